# Optimizing an MI355X kernel written in HIP

```python
import jax, jax.numpy as jnp
from jax import lax
import numpy as np

D_MODEL = 2048
BATCH = 4
SEQ = 2048
DEPTH = 4
DEC_BATCH = 128
DEC_SEQ = 8
PAST_LEN = 16384
PAGE_SIZE = 128

N_AB_LAYERS = (DEPTH + 1) // 2
N_LRU_LAYERS = DEPTH // 2
CONV_W = 4
H_A = 8
DK_A = 128
DV_A = 128
H_B = 4
DK_B = 128
DV_B = 256
GLA_LOWRANK = 16
GLA_NORMALIZER = 16.0
W_LRU = D_MODEL
LRU_BLOCKS = 16
LRU_BW = W_LRU // LRU_BLOCKS
LRU_C = 8.0
CHUNK_A = 64
CHUNK_B = 16
KA = H_A * DK_A
VA = H_A * DV_A
KB = H_B * DK_B
VB = H_B * DV_B
AB_IN = 2 * KA + VA + 2 * H_A + VA + 2 * KB + VB + GLA_LOWRANK + VB
AB_OUT = VA + VB
EPS = 1e-6

kernel_name = 'hybrid_gdn_gla_rglru_step'


def _rmsnorm(x, g):
    xf = x.astype(jnp.float32)
    y = xf * lax.rsqrt(jnp.mean(xf * xf, axis=-1, keepdims=True) + EPS)
    return (y * g.astype(jnp.float32)).astype(x.dtype)


def _l2norm(x):
    xf = x.astype(jnp.float32)
    return xf * lax.rsqrt(jnp.sum(xf * xf, axis=-1, keepdims=True) + EPS)


def _causal_conv(x, buf, w, b=None):
    K = w.shape[0]
    T = x.shape[1]
    xp = jnp.concatenate([buf.astype(x.dtype), x], axis=1)
    y = xp[:, 0:T] * w[0]
    for j in range(1, K):
        y = y + xp[:, j:j + T] * w[j]
    if b is not None:
        y = y + b
    return y, xp[:, T:]


def _to_chunks(a, C):
    B, T = a.shape[0], a.shape[1]
    N = -(-T // C)
    a = jnp.pad(a, [(0, 0), (0, N * C - T)] + [(0, 0)] * (a.ndim - 2))
    a = a.reshape((B, N, C) + a.shape[2:])
    return jnp.transpose(a, (1, 0, 3, 2) + tuple(range(4, a.ndim)))


def _from_chunks(o, T):
    N, B, H, C, D = o.shape
    return jnp.transpose(o, (1, 0, 3, 2, 4)).reshape(B, N * C, H, D)[:, :T]


def _gated_delta_rule(q, k, v, g, beta, S0):
    T = q.shape[1]
    DV = v.shape[-1]
    C = min(CHUNK_A, T)
    q, k, v, g, beta = [_to_chunks(a.astype(jnp.float32), C) for a in (q, k, v, g, beta)]
    G = jnp.cumsum(g, axis=-1)
    incl = jnp.tril(jnp.ones((C, C), bool))
    strict = jnp.tril(jnp.ones((C, C), bool), -1)
    diff = G[..., :, None] - G[..., None, :]
    decay = jnp.where(incl, jnp.exp(jnp.where(incl, diff, 0.0)), 0.0)
    kb = k * beta[..., None]
    A = jnp.where(strict, jnp.einsum('nbhid,nbhjd->nbhij', kb, k) * decay, 0.0)
    rhs = jnp.concatenate([v * beta[..., None], kb * jnp.exp(G)[..., None]], axis=-1)
    sol = lax.linalg.triangular_solve(A + jnp.eye(C, dtype=jnp.float32), rhs,
                                      left_side=True, lower=True, unit_diagonal=True)
    u, w = sol[..., :DV], sol[..., DV:]
    qk = jnp.einsum('nbhid,nbhjd->nbhij', q, k) * decay
    qg = q * jnp.exp(G)[..., None]

    def step(S, inp):
        qg_c, k_c, u_c, w_c, G_c, qk_c = inp
        v_new = u_c - jnp.einsum('bhck,bhkv->bhcv', w_c, S)
        o = jnp.einsum('bhck,bhkv->bhcv', qg_c, S) + jnp.einsum('bhij,bhjv->bhiv', qk_c, v_new)
        g_last = G_c[..., -1]
        k_dec = k_c * jnp.exp(g_last[..., None] - G_c)[..., None]
        S = S * jnp.exp(g_last)[..., None, None] + jnp.einsum('bhck,bhcv->bhkv', k_dec, v_new)
        return S, o

    S, o = lax.scan(step, S0.astype(jnp.float32), (qg, k, u, w, G, qk))
    return _from_chunks(o, T), S


def _gla(q, k, v, gk, S0):
    T = q.shape[1]
    C = min(CHUNK_B, T)
    q, k, v, gk = [_to_chunks(a.astype(jnp.float32), C) for a in (q, k, v, gk)]
    Bc = jnp.cumsum(gk, axis=-2)
    incl = jnp.tril(jnp.ones((C, C), bool))
    qg = q * jnp.exp(Bc)
    A = jnp.where(incl, jnp.einsum('nbhik,nbhjk->nbhij', qg, k * jnp.exp(-Bc)), 0.0)
    intra = jnp.einsum('nbhij,nbhjv->nbhiv', A, v)

    def step(S, inp):
        qg_c, k_c, v_c, B_c, intra_c = inp
        o = jnp.einsum('bhck,bhkv->bhcv', qg_c, S) + intra_c
        b_last = B_c[..., -1, :]
        k_dec = k_c * jnp.exp(b_last[..., None, :] - B_c)
        S = S * jnp.exp(b_last)[..., None] + jnp.einsum('bhck,bhcv->bhkv', k_dec, v_c)
        return S, o

    S, o = lax.scan(step, S0.astype(jnp.float32), (qg, k, v, Bc, intra))
    return _from_chunks(o, T), S


def _ab_split_points():
    sizes = [2 * KA + VA, H_A, H_A, VA, KB, KB, VB, GLA_LOWRANK, VB]
    return [int(s) for s in np.cumsum(sizes)[:-1]]


def _ab_mixer(x, S_a, conv_a, S_b, w_in, conv_w, a_log, dt_bias, norm_a, w_lr, b_lr, norm_b, w_out):
    B, T, _ = x.shape
    f32 = jnp.float32
    proj = jnp.einsum('btd,de->bte', x, w_in)
    qkv, b_raw, a_raw, z_a, q_b, k_b, v_b, lr_b, z_b = jnp.split(proj, _ab_split_points(), axis=-1)
    qkv, new_conv_a = _causal_conv(qkv, conv_a, conv_w)
    qkv = jax.nn.silu(qkv)
    q_a, k_a, v_a = jnp.split(qkv, [KA, 2 * KA], axis=-1)
    q_a = _l2norm(q_a.reshape(B, T, H_A, DK_A)) * (DK_A ** -0.5)
    k_a = _l2norm(k_a.reshape(B, T, H_A, DK_A))
    v_a = v_a.reshape(B, T, H_A, DV_A)
    beta = jax.nn.sigmoid(b_raw.astype(f32))
    g = -jnp.exp(a_log.astype(f32)) * jax.nn.softplus(a_raw.astype(f32) + dt_bias.astype(f32))
    o_a, S_a_new = _gated_delta_rule(q_a, k_a, v_a, g, beta, S_a)
    o_a = _rmsnorm(o_a.astype(x.dtype), norm_a) * jax.nn.silu(z_a.reshape(B, T, H_A, DV_A))
    q_b = q_b.reshape(B, T, H_B, DK_B) * (DK_B ** -0.5)
    k_b = k_b.reshape(B, T, H_B, DK_B)
    v_b = v_b.reshape(B, T, H_B, DV_B)
    gk = jax.nn.log_sigmoid((jnp.einsum('btr,rk->btk', lr_b, w_lr) + b_lr).astype(f32)) / GLA_NORMALIZER
    o_b, S_b_new = _gla(q_b, k_b, v_b, gk.reshape(B, T, H_B, DK_B), S_b)
    o_b = _rmsnorm(o_b.astype(x.dtype), norm_b) * jax.nn.silu(z_b.reshape(B, T, H_B, DV_B))
    o = jnp.concatenate([o_a.reshape(B, T, VA), o_b.reshape(B, T, VB)], axis=-1)
    return jnp.einsum('bte,ed->btd', o, w_out), S_a_new, new_conv_a, S_b_new


def _lru_mixer(x, h0, conv_buf, w_in, conv_w, conv_b, w_a, b_a, w_x, b_x, lam, w_out, reset_first):
    B, T, _ = x.shape
    f32 = jnp.float32
    xb, gate = jnp.split(jnp.einsum('btd,de->bte', x, w_in), 2, axis=-1)
    xc, new_buf = _causal_conv(xb, conv_buf, conv_w, conv_b)
    xh = xc.reshape(B, T, LRU_BLOCKS, LRU_BW)
    r = jax.nn.sigmoid((jnp.einsum('btnc,ncd->btnd', xh, w_a).reshape(B, T, W_LRU) + b_a).astype(f32))
    i = jax.nn.sigmoid((jnp.einsum('btnc,ncd->btnd', xh, w_x).reshape(B, T, W_LRU) + b_x).astype(f32))
    log_a = -LRU_C * r * jax.nn.softplus(-lam.astype(f32))
    a = jnp.exp(log_a)
    mult = jnp.sqrt(-jnp.expm1(2.0 * log_a))
    if reset_first:
        mult = mult.at[:, 0].set(1.0)
    bx = mult * i * xc.astype(f32)

    def step(h, inp):
        a_t, b_t = inp
        h = a_t * h + b_t
        return h, h

    hT, hs = lax.scan(step, h0.astype(f32), (jnp.swapaxes(a, 0, 1), jnp.swapaxes(bx, 0, 1)))
    y = jnp.swapaxes(hs, 0, 1).astype(x.dtype) * jax.nn.silu(gate)
    return jnp.einsum('btw,wd->btd', y, w_out), hT, new_buf


def _trunk(x, st_delta, st_dconv, st_gla, st_lru, st_lconv, ab_norm, ab_w_in, ab_conv_w, ab_a_log,
           ab_dt_bias, ab_norm_a, ab_gla_w_lr, ab_gla_b_lr, ab_norm_b, ab_w_out, lru_norm, lru_w_in,
           lru_conv_w, lru_conv_b, lru_w_a, lru_b_a, lru_w_x, lru_b_x, lru_lambda, lru_w_out,
           final_norm, reset_first):
    n_delta, n_dconv, n_gla, n_lru, n_lconv = [], [], [], [], []
    for l in range(DEPTH):
        j = l // 2
        if l % 2 == 0:
            h = _rmsnorm(x, ab_norm[j])
            y, sa, ca, sb = _ab_mixer(h, st_delta[j], st_dconv[j], st_gla[j], ab_w_in[j], ab_conv_w[j],
                                      ab_a_log[j], ab_dt_bias[j], ab_norm_a[j], ab_gla_w_lr[j],
                                      ab_gla_b_lr[j], ab_norm_b[j], ab_w_out[j])
            n_delta.append(sa)
            n_dconv.append(ca)
            n_gla.append(sb)
        else:
            h = _rmsnorm(x, lru_norm[j])
            y, hl, cl = _lru_mixer(h, st_lru[j], st_lconv[j], lru_w_in[j], lru_conv_w[j], lru_conv_b[j],
                                   lru_w_a[j], lru_b_a[j], lru_w_x[j], lru_b_x[j], lru_lambda[j],
                                   lru_w_out[j], reset_first)
            n_lru.append(hl)
            n_lconv.append(cl)
        x = x + y
    return (_rmsnorm(x, final_norm), jnp.stack(n_delta), jnp.stack(n_dconv), jnp.stack(n_gla),
            jnp.stack(n_lru), jnp.stack(n_lconv))


def setup_inputs(seed: int = 0) -> dict:
    key = jax.random.key(seed)
    ks = iter(jax.random.split(key, 32))
    f32 = jnp.float32

    def nrm(shape, scale):
        return jax.random.normal(next(ks), shape, f32) * scale

    NA, NL = N_AB_LAYERS, N_LRU_LAYERS
    out_scale = 0.5
    x_prompt = nrm((BATCH, SEQ, D_MODEL), 1.0)
    x_sample = nrm((DEC_BATCH, DEC_SEQ, D_MODEL), 1.0)
    state_delta = nrm((NA, DEC_BATCH, H_A, DK_A, DV_A), DK_A ** -0.5)
    state_delta_conv = nrm((NA, DEC_BATCH, CONV_W - 1, 2 * KA + VA), 1.0)
    state_gla = nrm((NA, DEC_BATCH, H_B, DK_B, DV_B), 0.1)
    state_lru = nrm((NL, DEC_BATCH, W_LRU), 0.5)
    state_lru_conv = nrm((NL, DEC_BATCH, CONV_W - 1, W_LRU), 1.0)
    ab_norm = 1.0 + nrm((NA, D_MODEL), 0.02)
    ab_w_in = nrm((NA, D_MODEL, AB_IN), D_MODEL ** -0.5)
    ab_conv_w = nrm((NA, CONV_W, 2 * KA + VA), CONV_W ** -0.5)
    ab_a_log = jnp.log(jax.random.uniform(next(ks), (NA, H_A), f32, 1.0, 16.0))
    dt = jnp.exp(jax.random.uniform(next(ks), (NA, H_A), f32, float(np.log(1e-3)), float(np.log(1e-1))))
    ab_dt_bias = dt + jnp.log(-jnp.expm1(-dt))
    ab_norm_a = 1.0 + nrm((NA, DV_A), 0.02)
    ab_gla_w_lr = nrm((NA, GLA_LOWRANK, KB), GLA_LOWRANK ** -0.5)
    ab_gla_b_lr = nrm((NA, KB), 0.01)
    ab_norm_b = 1.0 + nrm((NA, DV_B), 0.02)
    ab_w_out = nrm((NA, AB_OUT, D_MODEL), AB_OUT ** -0.5 * out_scale)
    lru_norm = 1.0 + nrm((NL, D_MODEL), 0.02)
    lru_w_in = nrm((NL, D_MODEL, 2 * W_LRU), D_MODEL ** -0.5)
    lru_conv_w = nrm((NL, CONV_W, W_LRU), CONV_W ** -0.5)
    lru_conv_b = nrm((NL, W_LRU), 0.01)
    lru_w_a = nrm((NL, LRU_BLOCKS, LRU_BW, LRU_BW), LRU_BW ** -0.5)
    lru_b_a = nrm((NL, W_LRU), 0.01)
    lru_w_x = nrm((NL, LRU_BLOCKS, LRU_BW, LRU_BW), LRU_BW ** -0.5)
    lru_b_x = nrm((NL, W_LRU), 0.01)
    u = jax.random.uniform(next(ks), (NL, W_LRU), f32, 0.9, 0.999)
    s = u ** (1.0 / LRU_C)
    lru_lambda = jnp.log(s) - jnp.log1p(-s)
    lru_w_out = nrm((NL, W_LRU, D_MODEL), W_LRU ** -0.5 * out_scale)
    final_norm = 1.0 + nrm((D_MODEL,), 0.02)
    return {'x_prompt': x_prompt, 'x_sample': x_sample,
            'state_delta': state_delta, 'state_delta_conv': state_delta_conv, 'state_gla': state_gla,
            'state_lru': state_lru, 'state_lru_conv': state_lru_conv,
            'ab_norm': ab_norm, 'ab_w_in': ab_w_in, 'ab_conv_w': ab_conv_w, 'ab_a_log': ab_a_log,
            'ab_dt_bias': ab_dt_bias, 'ab_norm_a': ab_norm_a, 'ab_gla_w_lr': ab_gla_w_lr,
            'ab_gla_b_lr': ab_gla_b_lr, 'ab_norm_b': ab_norm_b, 'ab_w_out': ab_w_out,
            'lru_norm': lru_norm, 'lru_w_in': lru_w_in, 'lru_conv_w': lru_conv_w, 'lru_conv_b': lru_conv_b,
            'lru_w_a': lru_w_a, 'lru_b_a': lru_b_a, 'lru_w_x': lru_w_x, 'lru_b_x': lru_b_x,
            'lru_lambda': lru_lambda, 'lru_w_out': lru_w_out, 'final_norm': final_norm}


def reference(x_prompt, x_sample, state_delta, state_delta_conv, state_gla, state_lru, state_lru_conv,
              ab_norm, ab_w_in, ab_conv_w, ab_a_log, ab_dt_bias, ab_norm_a, ab_gla_w_lr, ab_gla_b_lr,
              ab_norm_b, ab_w_out, lru_norm, lru_w_in, lru_conv_w, lru_conv_b, lru_w_a, lru_b_a,
              lru_w_x, lru_b_x, lru_lambda, lru_w_out, final_norm):
    weights = (ab_norm, ab_w_in, ab_conv_w, ab_a_log, ab_dt_bias, ab_norm_a, ab_gla_w_lr, ab_gla_b_lr,
               ab_norm_b, ab_w_out, lru_norm, lru_w_in, lru_conv_w, lru_conv_b, lru_w_a, lru_b_a,
               lru_w_x, lru_b_x, lru_lambda, lru_w_out, final_norm)
    Bp = x_prompt.shape[0]
    f32 = jnp.float32
    z_delta = jnp.zeros((N_AB_LAYERS, Bp, H_A, DK_A, DV_A), f32)
    z_dconv = jnp.zeros((N_AB_LAYERS, Bp, CONV_W - 1, 2 * KA + VA), x_prompt.dtype)
    z_gla = jnp.zeros((N_AB_LAYERS, Bp, H_B, DK_B, DV_B), f32)
    z_lru = jnp.zeros((N_LRU_LAYERS, Bp, W_LRU), f32)
    z_lconv = jnp.zeros((N_LRU_LAYERS, Bp, CONV_W - 1, W_LRU), x_prompt.dtype)
    y_prompt, p_delta, p_dconv, p_gla, p_lru, p_lconv = _trunk(
        x_prompt, z_delta, z_dconv, z_gla, z_lru, z_lconv, *weights, True)
    y_sample, s_delta, s_dconv, s_gla, s_lru, s_lconv = _trunk(
        x_sample, state_delta, state_delta_conv, state_gla, state_lru, state_lru_conv, *weights, False)
    return (y_prompt, y_sample, p_delta, p_dconv, p_gla, p_lru, p_lconv,
            s_delta, s_dconv, s_gla, s_lru, s_lconv)
```

```cpp
#include <hip/hip_runtime.h>
#include <hip/hip_cooperative_groups.h>
#include <cstdio>
#include <cstdint>
namespace cg = cooperative_groups;
namespace pg8 {
#define PG8_LAS __attribute__((address_space(3)))
typedef unsigned short bf16_t;
typedef short bf16x8 __attribute__((ext_vector_type(8)));
typedef float f32x4 __attribute__((ext_vector_type(4)));
typedef unsigned u32x4 __attribute__((ext_vector_type(4)));
constexpr int BM = 256, BK = 64, HALF = 128, HTB = HALF * BK * 2  , STAGE_BYTES = 8 * HTB, NXCD = 8, WGM = 8;

__host__ __device__ __forceinline__ int lds_byte(int r, int c) { const int st = (r >> 4) * 2 + (c >> 5), rr = r & 15, cc = c & 31, ob = rr * 64 + cc * 2; return st * 1024 + (ob ^ (((ob >> 9) & 1) << 5)); }
__host__ __device__ __forceinline__ void stage_rc(int b, int& R, int& C) { const int st = b / 1024, sb = b % 1024, swz = sb ^ (((sb >> 9) & 1) << 5); R = (st >> 1) * 16 + swz / 64; C = (st & 1) * 32 + (swz % 64) / 2; }
__host__ __device__ __forceinline__ int perm32(int rho) { const int n = rho >> 4, i = rho & 15; return 8 * (i >> 2) + 4 * n + (i & 3); }

struct Unit { int pm, pn; };
struct Gemm { const bf16_t* A; const bf16_t* Bt; int M, N, K; };

struct StaticOrder {
    int nM, nN, nwg, G, c;
    __host__ __device__ void init(int M, int N, int G_, int c_) { nM = M / BM; nN = N / BM; nwg = nM * nN; G = G_; c = c_; }
    __host__ __device__ bool next(int i, Unit& u) const {
        const long L = (long)i * G + c; if (L >= nwg) return false;
        int wgid = (int)L; { const int q = nwg / NXCD, r = nwg % NXCD, xcd = wgid % NXCD, off = wgid / NXCD; wgid = (xcd < r ? xcd * (q + 1) : r * (q + 1) + (xcd - r) * q) + off; }
        const int nig = WGM * nN, gid = wgid / nig, fm = gid * WGM, gsz = (nM - fm) < WGM ? (nM - fm) : WGM;
        u.pm = fm + ((wgid % nig) % gsz); u.pn = (wgid % nig) / gsz; return true;
    }
    __device__ __forceinline__ void a_ready(const Unit&) const {}
    __device__ __forceinline__ void done(const Unit&) const {}
};

__device__ __forceinline__ unsigned cvt_pk_bf16(float lo, float hi) { unsigned r; asm volatile("v_cvt_pk_bf16_f32 %0, %1, %2" : "=v"(r) : "v"(lo), "v"(hi)); return r; }
typedef float f32x2 __attribute__((ext_vector_type(2)));
struct EpiProj {
    static constexpr bool PERM = true, AFTER_DRAIN = false;
    bf16_t* O; int ldc; const float* ss;
    __device__ __forceinline__ void operator()(const f32x4 (&acc)[2][2][4][2], const Unit& u, int wr, int wc, int fr, int fq) const {
        const int row0 = u.pm * BM + wr * 64 + fr, col0 = u.pn * BM + wc * 32 + 8 * fq;
#pragma unroll
        for (int ai = 0; ai < 2; ++ai)
#pragma unroll
            for (int m = 0; m < 4; ++m) { bf16_t* rowp = O + (size_t)(row0 + ai * HALF + m * 16) * ldc + col0;
                const float rs = ss ? rsqrtf(ss[row0 + ai * HALF + m * 16] * (1.0f / 2048.0f) + 1e-6f) : 1.0f;
#pragma unroll
                for (int bj = 0; bj < 2; ++bj) { const f32x4 v0 = acc[ai][bj][m][0] * rs, v1 = acc[ai][bj][m][1] * rs;
                    u32x4 w; w.x = cvt_pk_bf16(v0[0], v0[1]); w.y = cvt_pk_bf16(v0[2], v0[3]); w.z = cvt_pk_bf16(v1[0], v1[1]); w.w = cvt_pk_bf16(v1[2], v1[3]);
                    *(u32x4*)(rowp + bj * HALF) = w; } }
    }
};
struct EpiRes {
    static constexpr bool PERM = false, AFTER_DRAIN = false;
    const float* baseP; const float* baseS; float* out; int ldc;
    bf16_t* Hn; const float* gn; float* ss;
    __device__ __forceinline__ void operator()(const f32x4 (&acc)[2][2][4][2], const Unit& u, int wr, int wc, int fr, int fq) const {
        const int row0 = u.pm * BM + wr * 64 + fr, col0 = u.pn * BM + wc * 32 + 4 * fq;
        f32x4 g4[2][2];
        if (Hn) {
#pragma unroll
            for (int bj = 0; bj < 2; ++bj)
#pragma unroll
                for (int n = 0; n < 2; ++n) g4[bj][n] = *(const f32x4*)(gn + col0 + bj * HALF + n * 16);
        }
#pragma unroll
        for (int ai = 0; ai < 2; ++ai)
#pragma unroll
            for (int m = 0; m < 4; ++m) { const int row = row0 + ai * HALF + m * 16;
                const float* bp = (row < 8192 ? baseP + (size_t)row * ldc : baseS + (size_t)(row - 8192) * ldc) + col0;
                float* op = out + (size_t)row * ldc + col0;
                float part = 0.f;
#pragma unroll
                for (int bj = 0; bj < 2; ++bj)
#pragma unroll
                    for (int n = 0; n < 2; ++n) { const f32x4 v = *(const f32x4*)(bp + bj * HALF + n * 16) + acc[ai][bj][m][n];
                        *(f32x4*)(op + bj * HALF + n * 16) = v;
                        if (Hn) { part += (v[0] * v[0] + v[1] * v[1]) + (v[2] * v[2] + v[3] * v[3]); const f32x4 gg = g4[bj][n];
                            unsigned w0 = cvt_pk_bf16(v[0] * gg[0], v[1] * gg[1]), w1 = cvt_pk_bf16(v[2] * gg[2], v[3] * gg[3]);
                            typedef unsigned u32x2 __attribute__((ext_vector_type(2)));
                            *(u32x2*)(Hn + (size_t)row * ldc + col0 + bj * HALF + n * 16) = (u32x2){w0, w1}; } }
                if (Hn) { part += __shfl_xor(part, 16); part += __shfl_xor(part, 32); if (fq == 0) unsafeAtomicAdd(ss + row, part); } }
    }
};
template <class Epi, class Sched, bool ALIGN_EPI = false, bool SP2 = false>
__device__ __forceinline__ void gemm_phase(PG8_LAS unsigned char* lds, const Gemm g, const Sched& S, const Epi& E) {
    int tid = threadIdx.x; asm volatile("" : "+v"(tid)); const int wid = __builtin_amdgcn_readfirstlane(tid >> 6), lane = tid & 63, wr = wid >> 2, wc = wid & 3, fr = lane & 15, fq = lane >> 4;
    const int K = g.K, nt = K / BK;
    unsigned voffA[2], voffB[2];
#pragma unroll
    for (int i = 0; i < 2; ++i) { int R, C; stage_rc(tid * 16 + i * 8192, R, C); const int Rb = Epi::PERM ? ((R & ~31) + perm32(R & 31)) : R;
        voffA[i] = (unsigned)(R * K + C) * 2u; voffB[i] = (unsigned)(Rb * K + C) * 2u; }
    const size_t kstep = (size_t)(BK * 2);
    const size_t hstep = (size_t)HALF * K * 2;
    const size_t tstep = 2 * hstep;
    const unsigned ldsw = (unsigned)wid * 1024u;
    const int aoff = lds_byte(wr * 64 + fr, fq * 8), boff = lds_byte(wc * 32 + fr, fq * 8);
#define PG8_SA(b, h) (((b) * 2 + (h)) * HTB)
#define PG8_SB(b, h) ((4 + (b) * 2 + (h)) * HTB)
#define PG8_STAGE(bufoff, gbase, voff) do { _Pragma("unroll") for (int _i = 0; _i < 2; ++_i) \
        __builtin_amdgcn_global_load_lds((const unsigned*)((const char*)(gbase) + (voff)[_i]), (PG8_LAS unsigned*)(lds + (bufoff) + ldsw + _i * 8192), 16, 0, 0); } while (0)
#define PG8_LDA(dst, b, h) do { _Pragma("unroll") for (int m = 0; m < 4; ++m) _Pragma("unroll") for (int k = 0; k < 2; ++k) dst[m][k] = *(const PG8_LAS bf16x8*)(lds + PG8_SA(b, h) + aoff + m * 2048 + k * 1024); } while (0)
#define PG8_LDB(dst, b, h) do { _Pragma("unroll") for (int n = 0; n < 2; ++n) _Pragma("unroll") for (int k = 0; k < 2; ++k) dst[n][k] = *(const PG8_LAS bf16x8*)(lds + PG8_SB(b, h) + boff + n * 2048 + k * 1024); } while (0)
#define PG8_MMA(ai, bj, At, Bt) do { __builtin_amdgcn_s_setprio(1); _Pragma("unroll") for (int m = 0; m < 4; ++m) _Pragma("unroll") for (int n = 0; n < 2; ++n) _Pragma("unroll") for (int k = 0; k < 2; ++k) \
        acc[ai][bj][m][n] = __builtin_amdgcn_mfma_f32_16x16x32_bf16(Bt[n][k], At[m][k], acc[ai][bj][m][n], 0, 0, 0); __builtin_amdgcn_s_setprio(0); } while (0)
#define PG8_WAIT_V(n) asm volatile("s_waitcnt vmcnt(" #n ")" ::: "memory")
#define PG8_WAIT_L(n) asm volatile("s_waitcnt lgkmcnt(" #n ")" ::: "memory")
#define PG8_BAR __builtin_amdgcn_s_barrier()
#define PG8_SCHED __builtin_amdgcn_sched_barrier(0)
    Unit cur, nxt; int ui = 0;
    if (!S.next(0, cur)) return;
    f32x4 acc[2][2][4][2];
#pragma unroll
    for (int a = 0; a < 2; ++a)
#pragma unroll
        for (int b = 0; b < 2; ++b)
#pragma unroll
            for (int m = 0; m < 4; ++m)
#pragma unroll
                for (int n = 0; n < 2; ++n) acc[a][b][m][n] = (f32x4){0.f, 0.f, 0.f, 0.f};
    bf16x8 At[4][2], B0[2][2], B1[2][2];
    const char* cA = (const char*)g.A + (size_t)cur.pm * tstep; const char* cB = (const char*)g.Bt + (size_t)cur.pn * tstep;
    S.a_ready(cur);
    if constexpr (SP2) {
        PG8_STAGE(PG8_SB(0, 0), cB, voffB); PG8_STAGE(PG8_SB(0, 1), cB + hstep, voffB); PG8_STAGE(PG8_SA(0, 0), cA, voffA); PG8_STAGE(PG8_SA(0, 1), cA + hstep, voffA);
        if (wr == 1) PG8_BAR;
        PG8_WAIT_V(2); PG8_BAR;
        PG8_STAGE(PG8_SB(1, 0), cB + kstep, voffB); PG8_STAGE(PG8_SA(1, 0), cA + kstep, voffA); PG8_STAGE(PG8_SB(1, 1), cB + hstep + kstep, voffB);
        PG8_WAIT_V(6); PG8_BAR;
    } else {
        PG8_STAGE(PG8_SB(0, 0), cB, voffB); PG8_STAGE(PG8_SA(0, 0), cA, voffA); PG8_STAGE(PG8_SB(0, 1), cB + hstep, voffB); PG8_STAGE(PG8_SA(0, 1), cA + hstep, voffA);
        if (wr == 1) PG8_BAR;
        PG8_WAIT_V(4); PG8_BAR;
        PG8_STAGE(PG8_SB(1, 0), cB + kstep, voffB); PG8_STAGE(PG8_SA(1, 0), cA + kstep, voffA); PG8_STAGE(PG8_SB(1, 1), cB + hstep + kstep, voffB);
        PG8_WAIT_V(6); PG8_BAR;
    }
    for (;;) {
        const bool has_next = S.next(ui + 1, nxt);
        const char* nA = has_next ? (const char*)g.A + (size_t)nxt.pm * tstep : cA; const char* nB = has_next ? (const char*)g.Bt + (size_t)nxt.pn * tstep : cB;
        for (int t = 0; t < nt; t += 2) {
            const bool last = (t == nt - 2);
            const char* a1 = cA + (size_t)(t + 1) * kstep;
            const char* a2 = last ? nA : cA + (size_t)(t + 2) * kstep; const char* b2 = last ? nB : cB + (size_t)(t + 2) * kstep;
            const char* a3 = a2 + kstep; const char* b3 = b2 + kstep;
            if (last && has_next) S.a_ready(nxt);
            if constexpr (SP2) {
            PG8_LDB(B0, 0, 0); PG8_LDB(B1, 0, 1); PG8_SCHED; PG8_LDA(At, 0, 0); PG8_STAGE(PG8_SA(1, 1), a1 + hstep, voffA);
            PG8_WAIT_V(8); PG8_WAIT_L(0); PG8_BAR; PG8_MMA(0, 0, At, B0); PG8_MMA(0, 1, At, B1); PG8_BAR; PG8_SCHED;
            PG8_LDA(At, 0, 1); PG8_STAGE(PG8_SB(0, 0), b2, voffB); PG8_STAGE(PG8_SB(0, 1), b2 + hstep, voffB); PG8_STAGE(PG8_SA(0, 0), a2, voffA);
            PG8_WAIT_V(8); PG8_WAIT_L(0); PG8_BAR; PG8_MMA(1, 0, At, B0); PG8_MMA(1, 1, At, B1); PG8_BAR; PG8_SCHED;
            PG8_LDB(B0, 1, 0); PG8_LDB(B1, 1, 1); PG8_SCHED; PG8_LDA(At, 1, 0); PG8_STAGE(PG8_SA(0, 1), a2 + hstep, voffA);
            PG8_WAIT_V(8); PG8_WAIT_L(0); PG8_BAR; PG8_MMA(0, 0, At, B0); PG8_MMA(0, 1, At, B1); PG8_BAR; PG8_SCHED;
            PG8_LDA(At, 1, 1); PG8_STAGE(PG8_SB(1, 0), b3, voffB); PG8_STAGE(PG8_SB(1, 1), b3 + hstep, voffB); PG8_STAGE(PG8_SA(1, 0), a3, voffA);
            PG8_WAIT_V(8); PG8_WAIT_L(0); PG8_BAR; PG8_MMA(1, 0, At, B0); PG8_MMA(1, 1, At, B1); PG8_BAR; PG8_SCHED;
            } else {
            PG8_LDB(B0, 0, 0); PG8_SCHED; PG8_LDA(At, 0, 0); PG8_STAGE(PG8_SA(1, 1), a1 + hstep, voffA);
            PG8_WAIT_L(8); PG8_BAR; PG8_WAIT_L(0); PG8_MMA(0, 0, At, B0); PG8_BAR; PG8_SCHED;
            PG8_LDB(B1, 0, 1); PG8_STAGE(PG8_SB(0, 0), b2, voffB);
            PG8_BAR; PG8_WAIT_L(0); PG8_MMA(0, 1, At, B1); PG8_BAR;
            PG8_LDA(At, 0, 1); PG8_STAGE(PG8_SA(0, 0), a2, voffA);
            PG8_BAR; PG8_WAIT_L(0); PG8_MMA(1, 0, At, B0); PG8_BAR; PG8_SCHED;
            PG8_STAGE(PG8_SB(0, 1), b2 + hstep, voffB);
            PG8_WAIT_V(6); PG8_BAR; PG8_MMA(1, 1, At, B1); PG8_BAR;
            PG8_LDB(B0, 1, 0); PG8_SCHED; PG8_LDA(At, 1, 0); PG8_STAGE(PG8_SA(0, 1), a2 + hstep, voffA);
            PG8_WAIT_L(8); PG8_BAR; PG8_WAIT_L(0); PG8_MMA(0, 0, At, B0); PG8_BAR; PG8_SCHED;
            PG8_LDB(B1, 1, 1); PG8_STAGE(PG8_SB(1, 0), b3, voffB);
            PG8_BAR; PG8_WAIT_L(0); PG8_MMA(0, 1, At, B1); PG8_BAR;
            PG8_LDA(At, 1, 1); PG8_STAGE(PG8_SA(1, 0), a3, voffA);
            PG8_BAR; PG8_WAIT_L(0); PG8_MMA(1, 0, At, B0); PG8_BAR; PG8_SCHED;
            PG8_STAGE(PG8_SB(1, 1), b3 + hstep, voffB);
            PG8_WAIT_V(6); PG8_BAR; PG8_MMA(1, 1, At, B1); PG8_BAR;
            }
        }
        if constexpr (ALIGN_EPI) { if (wr == 0) PG8_BAR; }
        if constexpr (!Epi::AFTER_DRAIN) { E(acc, cur, wr, wc, fr, fq); S.done(cur); }
        if (!has_next) break;
#pragma unroll
        for (int a = 0; a < 2; ++a)
#pragma unroll
            for (int b = 0; b < 2; ++b)
#pragma unroll
                for (int m = 0; m < 4; ++m)
#pragma unroll
                    for (int n = 0; n < 2; ++n) acc[a][b][m][n] = (f32x4){0.f, 0.f, 0.f, 0.f};
        cur = nxt; cA = nA; cB = nB; ++ui;
        if constexpr (ALIGN_EPI) { if (wr == 1) PG8_BAR; }
    }
    PG8_WAIT_V(0);
    if constexpr (!ALIGN_EPI) { if (wr == 0) PG8_BAR; }
    PG8_BAR;
    if constexpr (Epi::AFTER_DRAIN) { E.fused(acc, cur, wr, wc, fr, fq, lds, wid, lane); S.done(cur); }
#undef PG8_SA
#undef PG8_SB
#undef PG8_STAGE
#undef PG8_LDA
#undef PG8_LDB
#undef PG8_MMA
#undef PG8_WAIT_V
#undef PG8_WAIT_L
#undef PG8_BAR
#undef PG8_SCHED
}
}

#define LAS __attribute__((address_space(3)))
typedef unsigned short bf16;
typedef unsigned v4u __attribute__((ext_vector_type(4)));
typedef unsigned v2u __attribute__((ext_vector_type(2)));
typedef float f32x4 __attribute__((ext_vector_type(4)));
typedef short bf16x8 __attribute__((ext_vector_type(8)));

#ifndef ONE_LAUNCH
#define ONE_LAUNCH 1
#endif

constexpr int DM = 2048, NTOK = 9216, NPT = 8192, TP = 2048;
constexpr int ABNP = 7424;
constexpr int C_BRAW = 3072, C_ARAW = 3080, C_ZA = 3088, C_QB = 4112, C_KB = 4624, C_VB = 5136, C_LR = 6160, C_ZB = 6176;
constexpr float EPS = 1e-6f;
constexpr int NPHASE = 23;
constexpr int LDS_BYTES = 147456;

constexpr size_t O_YP = 0;
constexpr size_t O_YS = O_YP + (size_t)4 * 2048 * 2048;
constexpr size_t O_PDELTA = O_YS + (size_t)128 * 8 * 2048;
constexpr size_t O_PDCONV = O_PDELTA + (size_t)2 * 4 * 8 * 128 * 128;
constexpr size_t O_PGLA = O_PDCONV + (size_t)2 * 4 * 3 * 3072;
constexpr size_t O_PLRU = O_PGLA + (size_t)2 * 4 * 4 * 128 * 256;
constexpr size_t O_PLCONV = O_PLRU + (size_t)2 * 4 * 2048;
constexpr size_t O_SDELTA = O_PLCONV + (size_t)2 * 4 * 3 * 2048;
constexpr size_t O_SDCONV = O_SDELTA + (size_t)2 * 128 * 8 * 128 * 128;
constexpr size_t O_SGLA = O_SDCONV + (size_t)2 * 128 * 3 * 3072;
constexpr size_t O_SLRU = O_SGLA + (size_t)2 * 128 * 4 * 128 * 256;
constexpr size_t O_SLCONV = O_SLRU + (size_t)2 * 128 * 2048;
constexpr size_t O_END = O_SLCONV + (size_t)2 * 128 * 3 * 2048;
static_assert(O_END == 92676096, "output size");

constexpr size_t MiB = 1u << 20;
constexpr size_t WS_WABIN = 1 * MiB;
constexpr size_t WS_WABOUT = WS_WABIN + 58 * MiB;
constexpr size_t WS_WLIN = WS_WABOUT + 16 * MiB;
constexpr size_t WS_WLOUT = WS_WLIN + 32 * MiB;
constexpr size_t WS_WLA = WS_WLOUT + 16 * MiB;
constexpr size_t WS_WLX = WS_WLA + 1 * MiB;
constexpr size_t WS_X = WS_WLX + 1 * MiB;
constexpr size_t WS_H = WS_X + 72 * MiB;
constexpr size_t WS_O = WS_H + 36 * MiB;
constexpr size_t WS_PROJ = WS_O + 36 * MiB;
constexpr size_t WS_GW = WS_PROJ + 131 * MiB;
constexpr size_t WS_GQG = WS_GW + 16 * MiB;
constexpr size_t WS_GKDT = WS_GQG + 16 * MiB;
constexpr size_t WS_GQK = WS_GKDT + 16 * MiB;
constexpr size_t WS_GUT = WS_GQK + 8 * MiB;
constexpr size_t WS_LQG = WS_GUT + 32 * MiB;
constexpr size_t WS_LKDT = WS_LQG + 8 * MiB;
constexpr size_t WS_LA = WS_LKDT + 8 * MiB;
constexpr size_t WS_LVT = WS_LA + 4 * MiB;
constexpr size_t WS_GDEC = WS_LVT + 16 * MiB;
constexpr size_t WS_LDEC = WS_GDEC + 1 * MiB;
constexpr size_t WS_SUM = WS_LDEC + 1 * MiB;
constexpr size_t WS_CARRY = WS_SUM + 2 * MiB;
constexpr size_t WS_END = WS_CARRY + 4 * MiB;

struct Params { const float* in[28]; float* out; unsigned char* ws; int ph_lo, ph_hi; };

struct Ctx {
    const float* in[28];
    float* out;
    bf16 *WABIN, *WABOUT, *WLIN, *WLOUT, *WLA, *WLX;
    float* X; bf16 *H, *O, *PROJ;
    bf16 *G_W, *G_QG, *G_KDT, *G_QK; float* G_UT;
    bf16 *L_QG, *L_KDT, *L_A, *L_VT; float *G_DEC, *L_DEC, *SUM, *SS; unsigned long long* CARRY;
    int G;
};

__device__ __forceinline__ int otid() { int t = threadIdx.x; asm volatile("" : "+v"(t)); return t; }
__device__ __forceinline__ int obid() { int b = blockIdx.x; asm volatile("" : "+s"(b)); return b; }
__device__ __forceinline__ float bf2f(unsigned b) { return __uint_as_float(b << 16); }
typedef float cvf32x2 __attribute__((ext_vector_type(2)));
typedef __bf16 cvbf16x2 __attribute__((ext_vector_type(2)));
__device__ __forceinline__ unsigned pk2(float lo, float hi) { const cvf32x2 v = {lo, hi}; const cvbf16x2 r = __builtin_convertvector(v, cvbf16x2); return __builtin_bit_cast(unsigned, r); }
__device__ __forceinline__ unsigned f2bf(float f) { const __bf16 b = (__bf16)f; return (unsigned)__builtin_bit_cast(unsigned short, b); }
__device__ __forceinline__ void unpack8(v4u w, float (&f)[8]) {
    f[0] = __uint_as_float(w.x << 16); f[1] = __uint_as_float(w.x & 0xffff0000u);
    f[2] = __uint_as_float(w.y << 16); f[3] = __uint_as_float(w.y & 0xffff0000u);
    f[4] = __uint_as_float(w.z << 16); f[5] = __uint_as_float(w.z & 0xffff0000u);
    f[6] = __uint_as_float(w.w << 16); f[7] = __uint_as_float(w.w & 0xffff0000u);
}
__device__ __forceinline__ v4u pack8(const float (&f)[8]) { v4u w; w.x = pk2(f[0], f[1]); w.y = pk2(f[2], f[3]); w.z = pk2(f[4], f[5]); w.w = pk2(f[6], f[7]); return w; }
__device__ __forceinline__ float sigmoidf_(float x) { return __builtin_amdgcn_rcpf(1.0f + __expf(-x)); }
__device__ __forceinline__ float siluf_(float x) { return x * __builtin_amdgcn_rcpf(1.0f + __expf(-x)); }
#define LDS_BARRIER() do { asm volatile("s_waitcnt lgkmcnt(0)" ::: "memory"); __builtin_amdgcn_s_barrier(); asm volatile("" ::: "memory"); } while (0)
__device__ __forceinline__ float softplusf_(float x) { const float e = __expf(fminf(x, 20.f)); const float sp = (e < 0.03f) ? e * (1.0f - e * (0.5f - e * 0.33333333f)) : __logf(1.0f + e); return x > 20.f ? x : sp; }
__device__ __forceinline__ float logsigmoidf_(float x) { return fminf(x, 0.f) - __logf(1.0f + __expf(-fabsf(x))); }
__device__ __forceinline__ float wave_sum(float v) {
#pragma unroll
    for (int o = 1; o < 64; o <<= 1) v += __shfl_xor(v, o);
    return v;
}

__device__ __forceinline__ int frag_off(int row, int col, int nkk) { return (((row >> 4) * nkk + (col >> 5)) * 64 + ((col >> 3) & 3) * 16 + (row & 15)) * 8 + (col & 7); }
__device__ __forceinline__ int ufrag_off(int v, int c) { return (((v >> 4) * 4 + (c >> 4)) * 64 + ((c >> 2) & 3) * 16 + (v & 15)) * 4 + (c & 3); }
template <bool FRAG = false>
__device__ __forceinline__ void transpose_item(const float* W, int K, int N, bf16* WT, LAS float* scr, int item, int lane) {
    const int nblk = N / 32, kb = item / nblk, nb = item % nblk, k0 = 64 * kb, n0 = 32 * nb;
    float tv[32];
#pragma unroll
    for (int i = 0; i < 32; ++i) { const int kk = 2 * i + (lane >> 5); tv[i] = W[(size_t)(k0 + kk) * N + n0 + (lane & 31)]; }
#pragma unroll
    for (int i = 0; i < 32; ++i) { const int kk = 2 * i + (lane >> 5); scr[kk * 33 + (lane & 31)] = tv[i]; }
    asm volatile("s_waitcnt lgkmcnt(0)" ::: "memory");
    const int c = lane & 7;
#pragma unroll
    for (int j = 0; j < 4; ++j) { const int n = (lane >> 3) + 8 * j; const LAS float* s = scr + (8 * c) * 33 + n;
        v4u o; o.x = pk2(s[0 * 33], s[1 * 33]); o.y = pk2(s[2 * 33], s[3 * 33]); o.z = pk2(s[4 * 33], s[5 * 33]); o.w = pk2(s[6 * 33], s[7 * 33]);
        if (FRAG) *(v4u*)(WT + frag_off(n0 + n, k0 + 8 * c, K / 32)) = o;
        else *(v4u*)(WT + (size_t)(n0 + n) * K + k0 + 8 * c) = o; }
    asm volatile("s_waitcnt lgkmcnt(0)" ::: "memory");
}

__device__ __forceinline__ void rms_phase_bf16(const float* baseP, const float* baseS, const float* gw, bf16* Hout, int gwave, int ngw, int lane) {
    for (int m = gwave; m < NTOK; m += ngw) {
        const float* xr = (m < NPT) ? baseP + (size_t)m * DM : baseS + (size_t)(m - NPT) * DM;
        f32x4 v[8]; float ss = 0.f;
#pragma unroll
        for (int j = 0; j < 8; ++j) { v[j] = *(const f32x4*)(xr + (lane + 64 * j) * 4); ss += (v[j].x * v[j].x + v[j].y * v[j].y) + (v[j].z * v[j].z + v[j].w * v[j].w); }
        const float rinv = rsqrtf(wave_sum(ss) * (1.0f / DM) + EPS);
#pragma unroll
        for (int j = 0; j < 8; ++j) { const f32x4 g = *(const f32x4*)(gw + (lane + 64 * j) * 4);
            v2u o; o.x = pk2(v[j].x * rinv * g.x, v[j].y * rinv * g.y); o.y = pk2(v[j].z * rinv * g.z, v[j].w * rinv * g.w);
            *(v2u*)(Hout + (size_t)m * DM + (lane + 64 * j) * 4) = o; }
    }
}
__device__ __forceinline__ void rms_phase_f32(const float* X, const float* gw, float* out, int gwave, int ngw, int lane) {
    for (int m = gwave; m < NTOK; m += ngw) {
        const float* xr = X + (size_t)m * DM;
        f32x4 v[8]; float ss = 0.f;
#pragma unroll
        for (int j = 0; j < 8; ++j) { v[j] = *(const f32x4*)(xr + (lane + 64 * j) * 4); ss += (v[j].x * v[j].x + v[j].y * v[j].y) + (v[j].z * v[j].z + v[j].w * v[j].w); }
        const float rinv = rsqrtf(wave_sum(ss) * (1.0f / DM) + EPS);
#pragma unroll
        for (int j = 0; j < 8; ++j) { const f32x4 g = *(const f32x4*)(gw + (lane + 64 * j) * 4);
            f32x4 o; o.x = v[j].x * rinv * g.x; o.y = v[j].y * rinv * g.y; o.z = v[j].z * rinv * g.z; o.w = v[j].w * rinv * g.w;
            *(f32x4*)(out + (size_t)m * DM + (lane + 64 * j) * 4) = o; }
    }
}

constexpr int I_ABIN = 32 * 225, I_SQ = 32 * 64, I_LIN = 32 * 128, I_BLK = 2 * 4;
constexpr int OFF_ABOUT = 2 * I_ABIN, OFF_LIN = OFF_ABOUT + 2 * I_SQ, OFF_LOUT = OFF_LIN + 2 * I_LIN, OFF_WL = OFF_LOUT + 2 * I_SQ;
__device__ __forceinline__ void convert_item(const Ctx& C, int it, LAS float* scr, int lane) {
    int r = it;
    if (r < 2 * I_ABIN) { const int l = r / I_ABIN; r -= l * I_ABIN; transpose_item(C.in[8] + (size_t)l * 2048 * 7200, 2048, 7200, C.WABIN + (size_t)l * ABNP * 2048, scr, r, lane); return; } r -= 2 * I_ABIN;
    if (r < 2 * I_SQ) { const int l = r / I_SQ; r -= l * I_SQ; transpose_item(C.in[16] + (size_t)l * 2048 * 2048, 2048, 2048, C.WABOUT + (size_t)l * 2048 * 2048, scr, r, lane); return; } r -= 2 * I_SQ;
    if (r < 2 * I_LIN) { const int l = r / I_LIN; r -= l * I_LIN; transpose_item(C.in[18] + (size_t)l * 2048 * 4096, 2048, 4096, C.WLIN + (size_t)l * 4096 * 2048, scr, r, lane); return; } r -= 2 * I_LIN;
    if (r < 2 * I_SQ) { const int l = r / I_SQ; r -= l * I_SQ; transpose_item(C.in[26] + (size_t)l * 2048 * 2048, 2048, 2048, C.WLOUT + (size_t)l * 2048 * 2048, scr, r, lane); return; } r -= 2 * I_SQ;
    { const int which = r / (32 * I_BLK); r -= which * 32 * I_BLK; const int blk = r / I_BLK; r -= blk * I_BLK;
      transpose_item<true>((which ? C.in[23] : C.in[21]) + (size_t)blk * 16384, 128, 128, (which ? C.WLX : C.WLA) + (size_t)blk * 16384, scr, r, lane); }
}
__device__ __forceinline__ void convert_range(const Ctx& C, LAS float* scr, int lo, int hi, int wv, int nw, int lane) {
    if (wv < 0) return;
    for (int it = lo + wv; it < hi; it += nw) convert_item(C, it, scr, lane);
}
__device__ __forceinline__ void convert_segment(const Ctx& C, LAS unsigned char* lds, int seg, int first_idle_block) {
    const int tid = otid(), lane = tid & 63, wave = tid >> 6, bidx = obid();
    if (bidx < first_idle_block) return;
    LAS float* scr = (LAS float*)(lds + wave * 16384);
    const int wv = (bidx - first_idle_block) * 8 + wave, nw = (C.G - first_idle_block) * 8;
    if (seg == 1) {
        convert_range(C, scr, OFF_ABOUT, OFF_ABOUT + I_SQ, wv, nw, lane);
        convert_range(C, scr, OFF_LIN, OFF_LIN + I_LIN, wv, nw, lane);
        convert_range(C, scr, OFF_LOUT, OFF_LOUT + I_SQ, wv, nw, lane);
        convert_range(C, scr, OFF_WL, OFF_WL + 128, wv, nw, lane);
        convert_range(C, scr, OFF_WL + 256, OFF_WL + 384, wv, nw, lane);
    } else if (seg == 2) {
        convert_range(C, scr, I_ABIN, 2 * I_ABIN, wv, nw, lane);
    } else if (seg == 3) {
        convert_range(C, scr, OFF_ABOUT + I_SQ, OFF_ABOUT + 2 * I_SQ, wv, nw, lane);
        convert_range(C, scr, OFF_LIN + I_LIN, OFF_LIN + 2 * I_LIN, wv, nw, lane);
        convert_range(C, scr, OFF_WL + 128, OFF_WL + 256, wv, nw, lane);
        convert_range(C, scr, OFF_WL + 384, OFF_WL + 512, wv, nw, lane);
    } else {
        convert_range(C, scr, OFF_LOUT + I_SQ, OFF_LOUT + 2 * I_SQ, wv, nw, lane);
    }
}
__device__ __forceinline__ void prologue_phase(const Ctx& C, LAS unsigned char* lds) {
    const int tid = otid(), lane = tid & 63, wave = tid >> 6;
    LAS float* scr = (LAS float*)(lds + wave * 16384);
    const int bidx = obid(); const int gw = bidx * 8 + wave, NGW = C.G * 8;
    convert_range(C, scr, 0, (C.G == 256) ? I_ABIN : OFF_WL + 512, gw, NGW, lane);
    { const int gt = bidx * 512 + tid, ngt = C.G * 512; constexpr int PADV = 224 * 2048 / 8;
      for (int i = gt; i < 2 * PADV; i += ngt) { const int l = i / PADV, j = i % PADV; *(v4u*)(C.WABIN + (size_t)l * ABNP * 2048 + (size_t)7200 * 2048 + (size_t)j * 8) = (v4u){0u, 0u, 0u, 0u}; } }
    rms_phase_bf16(C.in[0], C.in[1], C.in[7], C.H, gw, NGW, lane);
}

__device__ __forceinline__ void gdn_prep_item(const Ctx& C, int layer, int item, LAS unsigned char* lds) {
    const int tid = otid(), lane = tid & 63, wid = tid >> 6, l15 = lane & 15, quad = lane >> 4;
    const int n = item & 31, h = (item >> 5) & 7, b = item >> 8;
    const size_t ch = (size_t)n * 32 + (item >> 5);
    LAS float* sQ = (LAS float*)lds;
    LAS float* sK = sQ + 64 * 132;
    LAS float* sV = sK + 64 * 132;
    LAS float* sA = sV + 64 * 132;
    LAS float* sBeta = sA + 64 * 64;
    LAS float* sG = sBeta + 64;
    LAS bf16* sQKb = (LAS bf16*)(sG + 64);
    const bf16* proj = C.PROJ;
    const float* cw = C.in[9] + (size_t)layer * 4 * 3072;
#pragma unroll 2
    for (int idx = tid; idx < 3072; idx += 512) {
        const int r = idx / 48, cg = idx % 48, part = cg >> 4, c8 = (cg & 15) * 8;
        const int col = part * 1024 + h * 128 + c8;
        float acc[8];
#pragma unroll
        for (int e = 0; e < 8; ++e) acc[e] = 0.f;
#pragma unroll
        for (int j = 0; j < 4; ++j) {
            const int t = n * 64 + r - 3 + j;
            if (t >= 0) {
                const v4u w = *(const v4u*)(proj + (size_t)(b * TP + t) * ABNP + col);
                float x[8]; unpack8(w, x);
                const f32x4 w0 = *(const f32x4*)(cw + j * 3072 + col), w1 = *(const f32x4*)(cw + j * 3072 + col + 4);
                acc[0] += x[0] * w0.x; acc[1] += x[1] * w0.y; acc[2] += x[2] * w0.z; acc[3] += x[3] * w0.w;
                acc[4] += x[4] * w1.x; acc[5] += x[5] * w1.y; acc[6] += x[6] * w1.z; acc[7] += x[7] * w1.w;
                if (j == 3 && n == 31 && r >= 61) {
                    float* o = C.out + O_PDCONV + ((size_t)(layer * 4 + b) * 3 + (r - 61)) * 3072 + col;
                    *(f32x4*)o = (f32x4){x[0], x[1], x[2], x[3]}; *(f32x4*)(o + 4) = (f32x4){x[4], x[5], x[6], x[7]};
                }
            }
        }
        LAS float* dst = (part == 0 ? sQ : (part == 1 ? sK : sV)) + r * 132 + c8;
        *(LAS f32x4*)dst = (f32x4){siluf_(acc[0]), siluf_(acc[1]), siluf_(acc[2]), siluf_(acc[3])};
        *(LAS f32x4*)(dst + 4) = (f32x4){siluf_(acc[4]), siluf_(acc[5]), siluf_(acc[6]), siluf_(acc[7])};
    }
    __syncthreads();
#pragma unroll
    for (int rr = 0; rr < 8; ++rr) {
        const int r = wid * 8 + rr;
        { const float a0 = sQ[r * 132 + lane], a1 = sQ[r * 132 + 64 + lane]; const float sc = rsqrtf(wave_sum(a0 * a0 + a1 * a1) + EPS) * 0.08838834764831845f;
          sQ[r * 132 + lane] = a0 * sc; sQ[r * 132 + 64 + lane] = a1 * sc; }
        { const float a0 = sK[r * 132 + lane], a1 = sK[r * 132 + 64 + lane]; const float sc = rsqrtf(wave_sum(a0 * a0 + a1 * a1) + EPS);
          sK[r * 132 + lane] = a0 * sc; sK[r * 132 + 64 + lane] = a1 * sc; }
    }
    if (tid < 64) {
        const size_t row = (size_t)(b * TP + n * 64 + tid);
        const float braw = bf2f(proj[row * ABNP + C_BRAW + h]), araw = bf2f(proj[row * ABNP + C_ARAW + h]);
        const float beta = sigmoidf_(braw);
        float g = -__expf(C.in[10][layer * 8 + h]) * softplusf_(araw + C.in[11][layer * 8 + h]);
#pragma unroll
        for (int o = 1; o < 64; o <<= 1) { const float t = __shfl_up(g, o); if (lane >= o) g += t; }
        sBeta[tid] = beta; sG[tid] = g;
    }
    __syncthreads();
    {
        const int mi = wid >> 1;
#pragma unroll
        for (int tt = 0; tt < 2; ++tt) {
            const int nj = (wid & 1) * 2 + tt;
            f32x4 accA = {0.f, 0.f, 0.f, 0.f}, accQ = {0.f, 0.f, 0.f, 0.f};
            if (nj <= mi) {
#pragma unroll
                for (int k16 = 0; k16 < 8; ++k16) {
                    const f32x4 ka = *(const LAS f32x4*)(sK + (mi * 16 + l15) * 132 + k16 * 16 + quad * 4);
                    const f32x4 qa = *(const LAS f32x4*)(sQ + (mi * 16 + l15) * 132 + k16 * 16 + quad * 4);
                    const f32x4 kb = *(const LAS f32x4*)(sK + (nj * 16 + l15) * 132 + k16 * 16 + quad * 4);
#pragma unroll
                    for (int s = 0; s < 4; ++s) {
                        accA = __builtin_amdgcn_mfma_f32_16x16x4f32(ka[s], kb[s], accA, 0, 0, 0);
                        accQ = __builtin_amdgcn_mfma_f32_16x16x4f32(qa[s], kb[s], accQ, 0, 0, 0);
                    }
                }
            }
            const int j = nj * 16 + l15; const float Gj = sG[j];
            f32x4 av;
#pragma unroll
            for (int jj = 0; jj < 4; ++jj) {
                const int i = mi * 16 + quad * 4 + jj;
                const float dec = (i >= j) ? __expf(sG[i] - Gj) : 0.f;
                av[jj] = (i > j) ? sBeta[i] * accA[jj] * dec : 0.f;
                sQKb[i * 72 + j] = (bf16)f2bf((i >= j) ? accQ[jj] * dec : 0.f);
            }
            if (nj <= mi) *(LAS f32x4*)(sA + j * 64 + mi * 16 + quad * 4) = av;
        }
    }
    __syncthreads();
    {
        const float gl = sG[63];
        for (int idx = tid; idx < 1024; idx += 512) {
            const int r = (idx >> 8) * 16 + (idx & 15), c8 = ((idx >> 6) & 3) * 32 + ((idx >> 4) & 3) * 8; const float eg = __expf(sG[r]);
            float v[8];
#pragma unroll
            for (int e = 0; e < 8; ++e) v[e] = sQ[r * 132 + c8 + e] * eg;
            *(v4u*)(C.G_QG + ch * 8192 + idx * 8) = pack8(v);
        }
        for (int idx = tid; idx < 1024; idx += 512) {
            const int k = (idx >> 7) * 16 + (idx & 15), i8 = ((idx >> 6) & 1) * 32 + ((idx >> 4) & 3) * 8;
            float v[8];
#pragma unroll
            for (int e = 0; e < 8; ++e) v[e] = sK[(i8 + e) * 132 + k] * __expf(gl - sG[i8 + e]);
            *(v4u*)(C.G_KDT + ch * 8192 + idx * 8) = pack8(v);
        }
        { const int idx = tid;
          const int r = (idx >> 7) * 16 + (idx & 15), c8 = ((idx >> 6) & 1) * 32 + ((idx >> 4) & 3) * 8;
          *(v4u*)(C.G_QK + ch * 4096 + idx * 8) = *(const LAS v4u*)(sQKb + r * 72 + c8); }
        if (tid == 0) C.G_DEC[ch] = __expf(gl);
    }
    __syncthreads();
    if (tid < 256) {
        const int c = tid;
        LAS float* colp = (c < 128) ? (sV + c) : (sK + (c - 128));
#pragma unroll 1
        for (int I = 0; I < 4; ++I) {
            float sl[16];
#pragma unroll
            for (int ii = 0; ii < 16; ++ii) { const int i = I * 16 + ii; const float f = (c < 128) ? sBeta[i] : sBeta[i] * __expf(sG[i]); sl[ii] = colp[i * 132] * f; }
#pragma unroll 4
            for (int j = 0; j < I * 16; ++j) {
                const float x = colp[j * 132];
                const LAS float* ap = sA + j * 64 + I * 16;
                const f32x4 a0 = *(const LAS f32x4*)ap, a1 = *(const LAS f32x4*)(ap + 4), a2 = *(const LAS f32x4*)(ap + 8), a3 = *(const LAS f32x4*)(ap + 12);
                sl[0] -= a0.x * x; sl[1] -= a0.y * x; sl[2] -= a0.z * x; sl[3] -= a0.w * x;
                sl[4] -= a1.x * x; sl[5] -= a1.y * x; sl[6] -= a1.z * x; sl[7] -= a1.w * x;
                sl[8] -= a2.x * x; sl[9] -= a2.y * x; sl[10] -= a2.z * x; sl[11] -= a2.w * x;
                sl[12] -= a3.x * x; sl[13] -= a3.y * x; sl[14] -= a3.z * x; sl[15] -= a3.w * x;
            }
#pragma unroll
            for (int jj = 0; jj < 15; ++jj) {
                const LAS float* ap = sA + (I * 16 + jj) * 64 + I * 16;
                float a[16];
#pragma unroll
                for (int q4 = 0; q4 < 4; ++q4) { const f32x4 t = *(const LAS f32x4*)(ap + q4 * 4); a[q4 * 4] = t.x; a[q4 * 4 + 1] = t.y; a[q4 * 4 + 2] = t.z; a[q4 * 4 + 3] = t.w; }
#pragma unroll
                for (int ii = jj + 1; ii < 16; ++ii) sl[ii] -= a[ii] * sl[jj];
            }
#pragma unroll
            for (int ii = 0; ii < 16; ++ii) colp[(I * 16 + ii) * 132] = sl[ii];
        }
    }
    __syncthreads();
    for (int idx = tid; idx < 1024; idx += 512) {
        const int r = (idx >> 8) * 16 + (idx & 15), c8 = ((idx >> 6) & 3) * 32 + ((idx >> 4) & 3) * 8;
        float v[8];
#pragma unroll
        for (int e = 0; e < 8; ++e) v[e] = sK[r * 132 + c8 + e];
        *(v4u*)(C.G_W + ch * 8192 + idx * 8) = pack8(v);
    }
    for (int idx = tid; idx < 2048; idx += 512) {
        const int v = (idx >> 8) * 16 + (idx & 15), c = ((idx >> 6) & 3) * 16 + ((idx >> 4) & 3) * 4;
        *(f32x4*)(C.G_UT + ch * 8192 + idx * 4) = (f32x4){sV[c * 132 + v], sV[(c + 1) * 132 + v], sV[(c + 2) * 132 + v], sV[(c + 3) * 132 + v]};
    }
    __syncthreads();
}

__device__ __forceinline__ void gla_prep_item(const Ctx& C, int layer, int item, LAS unsigned char* lds) {
    const int tid = otid(), lane = tid & 63, wid = tid >> 6, l15 = lane & 15, quad = lane >> 4;
    const int n = item & 31, h = (item >> 5) & 3, b = item >> 7;
    const size_t ch = (size_t)n * 16 + (item >> 5);
    const size_t tok0 = (size_t)b * TP + n * 64;
    LAS float* sQG = (LAS float*)lds;
    LAS float* sKN = sQG + 64 * 132;
    LAS float* sBc = sKN + 64 * 132;
    LAS float* sLR = sBc + 64 * 132;
    LAS bf16* sAb = (LAS bf16*)(sLR + 1024);
    const bf16* proj = C.PROJ;
    for (int idx = tid; idx < 1024; idx += 512) { const int r = idx >> 4, m = idx & 15; sLR[idx] = bf2f(proj[(tok0 + r) * ABNP + C_LR + m]); }
    __syncthreads();
    {
        const int k = tid & 127, rg = tid >> 7;
        float wl[16];
#pragma unroll
        for (int m = 0; m < 16; ++m) wl[m] = C.in[13][(size_t)(layer * 16 + m) * 512 + h * 128 + k];
        const float bl = C.in[14][layer * 512 + h * 128 + k];
        for (int r = rg * 16; r < rg * 16 + 16; ++r) {
            float x = bl;
#pragma unroll
            for (int m = 0; m < 16; ++m) x += sLR[r * 16 + m] * wl[m];
            sBc[r * 132 + k] = logsigmoidf_(x) * (1.0f / 16.0f);
        }
    }
    __syncthreads();
    if (tid < 128) { float acc = 0.f;
#pragma unroll 16
        for (int r = 0; r < 64; ++r) { acc += sBc[r * 132 + tid]; sBc[r * 132 + tid] = acc; } }
    __syncthreads();
    for (int idx = tid; idx < 1024; idx += 512) {
        const int r = idx >> 4, c8 = (idx & 15) * 8;
        float q[8], k[8], qg[8];
        unpack8(*(const v4u*)(proj + (tok0 + r) * ABNP + C_QB + h * 128 + c8), q);
        unpack8(*(const v4u*)(proj + (tok0 + r) * ABNP + C_KB + h * 128 + c8), k);
#pragma unroll
        for (int e = 0; e < 8; ++e) { const float bc = sBc[r * 132 + c8 + e]; qg[e] = q[e] * 0.08838834764831845f * __expf(bc); sQG[r * 132 + c8 + e] = qg[e]; sKN[r * 132 + c8 + e] = k[e] * __expf(-bc); }
    }
    for (int idx = tid; idx < 2048; idx += 512) {
        const int v = idx & 255, i8 = (idx >> 8) * 8;
        float x[8];
#pragma unroll
        for (int e = 0; e < 8; ++e) x[e] = bf2f(proj[(tok0 + i8 + e) * ABNP + C_VB + h * 256 + v]);
        *(v4u*)(C.L_VT + ch * 16384 + frag_off(v, i8, 2)) = pack8(x);
    }
    __syncthreads();
    for (int idx = tid; idx < 1024; idx += 512) {
        const int r = (idx >> 8) * 16 + (idx & 15), c8 = ((idx >> 6) & 3) * 32 + ((idx >> 4) & 3) * 8;
        float v[8];
#pragma unroll
        for (int e = 0; e < 8; ++e) v[e] = sQG[r * 132 + c8 + e];
        *(v4u*)(C.L_QG + ch * 8192 + idx * 8) = pack8(v);
    }
    for (int idx = tid; idx < 1024; idx += 512) {
        const int k = (idx >> 7) * 16 + (idx & 15), i8 = ((idx >> 6) & 1) * 32 + ((idx >> 4) & 3) * 8; const float ebl = __expf(sBc[63 * 132 + k]);
        float v[8];
#pragma unroll
        for (int e = 0; e < 8; ++e) v[e] = sKN[(i8 + e) * 132 + k] * ebl;
        *(v4u*)(C.L_KDT + ch * 8192 + idx * 8) = pack8(v);
    }
    if (tid < 128) C.L_DEC[ch * 128 + tid] = __expf(sBc[63 * 132 + tid]);
    {
        const int mi = wid >> 1;
#pragma unroll
        for (int tt = 0; tt < 2; ++tt) {
            const int nj = (wid & 1) * 2 + tt;
            f32x4 acc = {0.f, 0.f, 0.f, 0.f};
            if (nj <= mi) {
#pragma unroll
                for (int k16 = 0; k16 < 8; ++k16) {
                    const f32x4 qa = *(const LAS f32x4*)(sQG + (mi * 16 + l15) * 132 + k16 * 16 + quad * 4);
                    const f32x4 kb = *(const LAS f32x4*)(sKN + (nj * 16 + l15) * 132 + k16 * 16 + quad * 4);
#pragma unroll
                    for (int s = 0; s < 4; ++s) acc = __builtin_amdgcn_mfma_f32_16x16x4f32(qa[s], kb[s], acc, 0, 0, 0);
                }
            }
            const int j = nj * 16 + l15;
#pragma unroll
            for (int jj = 0; jj < 4; ++jj) { const int i = mi * 16 + quad * 4 + jj; sAb[i * 72 + j] = (bf16)f2bf((i >= j) ? acc[jj] : 0.f); }
        }
    }
    __syncthreads();
    { const int idx = tid;
      const int r = (idx >> 7) * 16 + (idx & 15), c8 = ((idx >> 6) & 1) * 32 + ((idx >> 4) & 3) * 8;
      *(v4u*)(C.L_A + ch * 4096 + idx * 8) = *(const LAS v4u*)(sAb + r * 72 + c8); }
    __syncthreads();
}

template <bool HAS_W> struct ScanFr { bf16x8 aq[4]; bf16x8 aw[4]; bf16x8 aqk[2]; bf16x8 ak[2][2]; bf16x8 bvg[2]; f32x4 u; f32x4 dec[2]; };
template <bool HAS_W>
__device__ __forceinline__ void scan_load(ScanFr<HAS_W>& F, const Ctx& C, size_t ch, int s, int mi, int ni, int kt0, int l15, int quad) {
    const int lane8 = (quad * 16 + l15) * 8;
    const bf16* QG = (HAS_W ? C.G_QG : C.L_QG) + ch * 8192 + lane8;
    const bf16* KDT = (HAS_W ? C.G_KDT : C.L_KDT) + ch * 8192 + lane8;
    const bf16* QK = (HAS_W ? C.G_QK : C.L_A) + ch * 4096 + lane8;
#pragma unroll
    for (int kk = 0; kk < 4; ++kk) {
        F.aq[kk] = *(const bf16x8*)(QG + (mi * 4 + kk) * 512);
        if (HAS_W) F.aw[kk] = *(const bf16x8*)(C.G_W + ch * 8192 + lane8 + (mi * 4 + kk) * 512);
    }
#pragma unroll
    for (int kk = 0; kk < 2; ++kk) {
        F.aqk[kk] = *(const bf16x8*)(QK + (mi * 2 + kk) * 512);
#pragma unroll
        for (int t = 0; t < 2; ++t) F.ak[t][kk] = *(const bf16x8*)(KDT + ((kt0 + t) * 2 + kk) * 512);
        if (!HAS_W) F.bvg[kk] = *(const bf16x8*)(C.L_VT + ch * 16384 + lane8 + ((s * 2 + ni) * 2 + kk) * 512);
    }
    if (HAS_W) {
        F.u = *(const f32x4*)(C.G_UT + ch * 8192 + (((s * 2 + ni) * 4 + mi) * 64 + quad * 16 + l15) * 4);
        const float d = C.G_DEC[ch]; F.dec[0] = (f32x4){d, d, d, d}; F.dec[1] = F.dec[0];
    } else {
#pragma unroll
        for (int t = 0; t < 2; ++t) F.dec[t] = *(const f32x4*)(C.L_DEC + ch * 128 + (kt0 + t) * 16 + quad * 4);
    }
}
template <bool HAS_W>
__device__ __forceinline__ void scan_step(const ScanFr<HAS_W>& F, f32x4 (&Sacc)[2], LAS bf16* sST, LAS bf16* sVT, LAS bf16* sO, int mi, int ni, int kt0, int l15, int quad) {
    f32x4 acc_o = {0.f, 0.f, 0.f, 0.f}, acc_w = {0.f, 0.f, 0.f, 0.f};
#pragma unroll
    for (int kk = 0; kk < 4; ++kk) {
        const bf16x8 bfr = *(const LAS bf16x8*)(sST + (ni * 16 + l15) * 136 + kk * 32 + quad * 8);
        acc_o = __builtin_amdgcn_mfma_f32_16x16x32_bf16(F.aq[kk], bfr, acc_o, 0, 0, 0);
        if (HAS_W) acc_w = __builtin_amdgcn_mfma_f32_16x16x32_bf16(F.aw[kk], bfr, acc_w, 0, 0, 0);
    }
    if (HAS_W) {
        const f32x4 vn = F.u - acc_w;
        v2u o; o.x = pk2(vn.x, vn.y); o.y = pk2(vn.z, vn.w);
        *(LAS v2u*)(sVT + (ni * 16 + l15) * 72 + mi * 16 + quad * 4) = o;
    }
    LDS_BARRIER();
    bf16x8 bv[2];
#pragma unroll
    for (int kk = 0; kk < 2; ++kk) {
        if (HAS_W) bv[kk] = *(const LAS bf16x8*)(sVT + (ni * 16 + l15) * 72 + kk * 32 + quad * 8);
        else bv[kk] = F.bvg[kk];
    }
#pragma unroll
    for (int kk = 0; kk < 2; ++kk) acc_o = __builtin_amdgcn_mfma_f32_16x16x32_bf16(F.aqk[kk], bv[kk], acc_o, 0, 0, 0);
#pragma unroll
    for (int j = 0; j < 4; ++j) sO[(mi * 16 + quad * 4 + j) * 40 + ni * 16 + l15] = (bf16)f2bf(acc_o[j]);
#pragma unroll
    for (int t = 0; t < 2; ++t) {
        Sacc[t] = Sacc[t] * F.dec[t];
#pragma unroll
        for (int kk = 0; kk < 2; ++kk) Sacc[t] = __builtin_amdgcn_mfma_f32_16x16x32_bf16(F.ak[t][kk], bv[kk], Sacc[t], 0, 0, 0);
        v2u o; o.x = pk2(Sacc[t].x, Sacc[t].y); o.y = pk2(Sacc[t].z, Sacc[t].w);
        *(LAS v2u*)(sST + (ni * 16 + l15) * 136 + (kt0 + t) * 16 + quad * 4) = o;
    }
    LDS_BARRIER();
}
template <bool HAS_W>
__device__ __forceinline__ void scan_task(const Ctx& C, int layer, int task, LAS unsigned char* lds) {
    const int tid = otid(), lane = tid & 63, w = tid >> 6, l15 = lane & 15, quad = lane >> 4;
    const int s = HAS_W ? (task & 3) : (task & 7), bh = HAS_W ? (task >> 2) : (task >> 3);
    const int b = HAS_W ? (bh >> 3) : (bh >> 2), h = HAS_W ? (bh & 7) : (bh & 3);
    const int mi = w >> 1, ni = w & 1, kt0 = (w >> 1) * 2;
    LAS bf16* sST = (LAS bf16*)lds;
    LAS bf16* sVT = sST + 32 * 136;
    LAS bf16* sO = sVT + 32 * 72;
    f32x4 Sacc[2]; Sacc[0] = (f32x4){0.f, 0.f, 0.f, 0.f}; Sacc[1] = Sacc[0];
    for (int i = tid; i < 32 * 136 / 2; i += 512) ((LAS unsigned*)sST)[i] = 0u;
    const int colbase = HAS_W ? (h * 128 + s * 32) : (1024 + h * 256 + s * 32);
    bf16* OA = C.H + (size_t)b * TP * DM + colbase;
    const int NBH = HAS_W ? 32 : 16;
    ScanFr<HAS_W> FA, FB;
    __syncthreads();
#pragma unroll 1
    for (int n = 0; n < 32; n += 2) {
        scan_load<HAS_W>(FA, C, (size_t)n * NBH + bh, s, mi, ni, kt0, l15, quad);
        scan_load<HAS_W>(FB, C, (size_t)(n + 1) * NBH + bh, s, mi, ni, kt0, l15, quad);
        scan_step<HAS_W>(FA, Sacc, sST, sVT, sO, mi, ni, kt0, l15, quad);
        scan_step<HAS_W>(FB, Sacc, sST, sVT, sO + 64 * 40, mi, ni, kt0, l15, quad);
        {
            const int r = tid >> 2, sgm = tid & 3;
            const v4u ov = *(const LAS v4u*)(sO + r * 40 + sgm * 8);
            *(v4u*)(OA + (size_t)(n * 64 + r) * DM + sgm * 8) = ov;
        }
    }
    const int DV = HAS_W ? 128 : 256;
    float* outS = C.out + (HAS_W ? O_PDELTA + (size_t)((layer * 4 + b) * 8 + h) * 128 * 128 : O_PGLA + (size_t)((layer * 4 + b) * 4 + h) * 128 * 256);
#pragma unroll
    for (int t = 0; t < 2; ++t)
#pragma unroll
        for (int j = 0; j < 4; ++j) outS[(size_t)((kt0 + t) * 16 + quad * 4 + j) * DV + s * 32 + ni * 16 + l15] = Sacc[t][j];
    __syncthreads();
}

__device__ __forceinline__ void gdn_sample_item(const Ctx& C, int layer, int item, LAS unsigned char* lds) {
    const int tid = otid(), lane = tid & 63, wid = tid >> 6;
    const int h = item & 7, b = item >> 3;
    LAS float* sq = (LAS float*)lds;
    LAS float* sk = sq + 1024;
    LAS float* sv = sk + 1024;
    LAS float* so = sv + 1024;
    LAS float* red = so + 1024;
    LAS float* red2 = red + 512;
    LAS float* sbeta = red2 + 512;
    LAS float* seg = sbeta + 8;
    const bf16* proj = C.PROJ;
    const size_t tokS = (size_t)NPT + b * 8;
    const float* cw = C.in[9] + (size_t)layer * 4 * 3072;
    if (tid < 384) {
        const int t = tid / 48, cg = tid % 48, part = cg >> 4, c8 = (cg & 15) * 8;
        const int col = part * 1024 + h * 128 + c8;
        float acc[8];
#pragma unroll
        for (int e = 0; e < 8; ++e) acc[e] = 0.f;
#pragma unroll
        for (int j = 0; j < 4; ++j) {
            const int tl = t - 3 + j;
            float x[8];
            if (tl >= 0) unpack8(*(const v4u*)(proj + (tokS + tl) * ABNP + col), x);
            else { const float* sp = C.in[3] + ((size_t)(layer * 128 + b) * 3 + (3 + tl)) * 3072 + col;
                const f32x4 a = *(const f32x4*)sp, c = *(const f32x4*)(sp + 4); x[0] = a.x; x[1] = a.y; x[2] = a.z; x[3] = a.w; x[4] = c.x; x[5] = c.y; x[6] = c.z; x[7] = c.w; }
            const f32x4 w0 = *(const f32x4*)(cw + j * 3072 + col), w1 = *(const f32x4*)(cw + j * 3072 + col + 4);
            acc[0] += x[0] * w0.x; acc[1] += x[1] * w0.y; acc[2] += x[2] * w0.z; acc[3] += x[3] * w0.w;
            acc[4] += x[4] * w1.x; acc[5] += x[5] * w1.y; acc[6] += x[6] * w1.z; acc[7] += x[7] * w1.w;
            if (j == 3 && t >= 5) {
                float* o = C.out + O_SDCONV + ((size_t)(layer * 128 + b) * 3 + (t - 5)) * 3072 + col;
                *(f32x4*)o = (f32x4){x[0], x[1], x[2], x[3]}; *(f32x4*)(o + 4) = (f32x4){x[4], x[5], x[6], x[7]};
            }
        }
        LAS float* dst = (part == 0 ? sq : (part == 1 ? sk : sv)) + t * 128 + c8;
        *(LAS f32x4*)dst = (f32x4){siluf_(acc[0]), siluf_(acc[1]), siluf_(acc[2]), siluf_(acc[3])};
        *(LAS f32x4*)(dst + 4) = (f32x4){siluf_(acc[4]), siluf_(acc[5]), siluf_(acc[6]), siluf_(acc[7])};
    }
    __syncthreads();
    {
        const int r = wid;
        { const float a0 = sq[r * 128 + lane], a1 = sq[r * 128 + 64 + lane]; const float sc = rsqrtf(wave_sum(a0 * a0 + a1 * a1) + EPS) * 0.08838834764831845f;
          sq[r * 128 + lane] = a0 * sc; sq[r * 128 + 64 + lane] = a1 * sc; }
        { const float a0 = sk[r * 128 + lane], a1 = sk[r * 128 + 64 + lane]; const float sc = rsqrtf(wave_sum(a0 * a0 + a1 * a1) + EPS);
          sk[r * 128 + lane] = a0 * sc; sk[r * 128 + 64 + lane] = a1 * sc; }
        if (tid < 8) {
            const float braw = bf2f(proj[(tokS + tid) * ABNP + C_BRAW + h]), araw = bf2f(proj[(tokS + tid) * ABNP + C_ARAW + h]);
            sbeta[tid] = sigmoidf_(braw);
            seg[tid] = __expf(-__expf(C.in[10][layer * 8 + h]) * softplusf_(araw + C.in[11][layer * 8 + h]));
        }
    }
    const int v = tid & 127, kg = tid >> 7;
    float S[32];
    { const float* sp = C.in[2] + ((size_t)((layer * 128 + b) * 8 + h) * 128 + kg * 32) * 128 + v;
#pragma unroll
      for (int i = 0; i < 32; ++i) S[i] = sp[(size_t)i * 128]; }
    __syncthreads();
    for (int t = 0; t < 8; ++t) {
        const float eg = seg[t];
        float p = 0.f;
#pragma unroll
        for (int i = 0; i < 32; ++i) p += S[i] * sk[t * 128 + kg * 32 + i];
        red[kg * 128 + v] = p;
        __syncthreads();
        const float r = (red[v] + red[128 + v]) + (red[256 + v] + red[384 + v]);
        const float vn = sbeta[t] * (sv[t * 128 + v] - eg * r);
        float po = 0.f;
#pragma unroll
        for (int i = 0; i < 32; ++i) { S[i] = eg * S[i] + sk[t * 128 + kg * 32 + i] * vn; po += S[i] * sq[t * 128 + kg * 32 + i]; }
        red2[kg * 128 + v] = po;
        __syncthreads();
        if (kg == 0) so[t * 128 + v] = (red2[v] + red2[128 + v]) + (red2[256 + v] + red2[384 + v]);
    }
    { float* op = C.out + O_SDELTA + ((size_t)((layer * 128 + b) * 8 + h) * 128 + kg * 32) * 128 + v;
#pragma unroll
      for (int i = 0; i < 32; ++i) op[(size_t)i * 128] = S[i]; }
    __syncthreads();
    {
        const int t = wid;
        const float o0 = so[t * 128 + lane], o1 = so[t * 128 + 64 + lane];
        const float rstd = rsqrtf(wave_sum(o0 * o0 + o1 * o1) * (1.0f / 128.0f) + EPS);
        const float* nw = C.in[12] + layer * 128;
        const float z0 = bf2f(proj[(tokS + t) * ABNP + C_ZA + h * 128 + lane]), z1 = bf2f(proj[(tokS + t) * ABNP + C_ZA + h * 128 + 64 + lane]);
        C.O[(tokS + t) * DM + h * 128 + lane] = (bf16)f2bf(o0 * rstd * nw[lane] * siluf_(z0));
        C.O[(tokS + t) * DM + h * 128 + 64 + lane] = (bf16)f2bf(o1 * rstd * nw[64 + lane] * siluf_(z1));
    }
    __syncthreads();
}

__device__ __forceinline__ void gla_sample_item(const Ctx& C, int layer, int item, LAS unsigned char* lds) {
    const int tid = otid(), lane = tid & 63, wid = tid >> 6;
    const int h = item & 3, b = item >> 2;
    LAS float* sq = (LAS float*)lds;
    LAS float* sk = sq + 1024;
    LAS float* sgk = sk + 1024;
    LAS float* sv = sgk + 1024;
    LAS float* so = sv + 2048;
    LAS float* red = so + 2048;
    LAS float* slr = red + 4096;
    const bf16* proj = C.PROJ;
    const size_t tokS = (size_t)NPT + b * 8;
    if (tid < 128) slr[tid] = bf2f(proj[(tokS + (tid >> 4)) * ABNP + C_LR + (tid & 15)]);
    for (int idx = tid; idx < 1024; idx += 512) { const int t = idx >> 7, k = idx & 127;
        sq[idx] = bf2f(proj[(tokS + t) * ABNP + C_QB + h * 128 + k]) * 0.08838834764831845f; sk[idx] = bf2f(proj[(tokS + t) * ABNP + C_KB + h * 128 + k]); }
    for (int idx = tid; idx < 2048; idx += 512) { const int t = idx >> 8, vv = idx & 255; sv[idx] = bf2f(proj[(tokS + t) * ABNP + C_VB + h * 256 + vv]); }
    __syncthreads();
    for (int idx = tid; idx < 1024; idx += 512) { const int t = idx >> 7, k = idx & 127;
        float x = C.in[14][layer * 512 + h * 128 + k];
#pragma unroll
        for (int m = 0; m < 16; ++m) x += slr[t * 16 + m] * C.in[13][(size_t)(layer * 16 + m) * 512 + h * 128 + k];
        sgk[idx] = __expf(logsigmoidf_(x) * (1.0f / 16.0f)); }
    const int v4 = (tid & 63) * 4, k0 = (tid >> 6) * 16;
    f32x4 S[16];
    { const float* sp = C.in[4] + ((size_t)((layer * 128 + b) * 4 + h) * 128 + k0) * 256 + v4;
#pragma unroll
      for (int i = 0; i < 16; ++i) S[i] = *(const f32x4*)(sp + (size_t)i * 256); }
    __syncthreads();
    LAS float* red8 = red;
    for (int t = 0; t < 8; ++t) {
        const f32x4 vt = *(const LAS f32x4*)(sv + t * 256 + v4);
        f32x4 po = {0.f, 0.f, 0.f, 0.f};
#pragma unroll
        for (int i4 = 0; i4 < 4; ++i4) {
            const f32x4 g4 = *(const LAS f32x4*)(sgk + t * 128 + k0 + i4 * 4), kk4 = *(const LAS f32x4*)(sk + t * 128 + k0 + i4 * 4), q4 = *(const LAS f32x4*)(sq + t * 128 + k0 + i4 * 4);
#pragma unroll
            for (int e = 0; e < 4; ++e) { const int i = i4 * 4 + e; S[i] = S[i] * g4[e] + vt * kk4[e]; po = po + S[i] * q4[e]; }
        }
        *(LAS f32x4*)(red8 + (t & 1) * 2048 + (tid >> 6) * 256 + v4) = po;
        __syncthreads();
        if (tid < 256) { float a = 0.f;
#pragma unroll
            for (int g = 0; g < 8; ++g) a += red8[(t & 1) * 2048 + g * 256 + tid];
            so[t * 256 + tid] = a; }
    }
    { float* op = C.out + O_SGLA + ((size_t)((layer * 128 + b) * 4 + h) * 128 + k0) * 256 + v4;
#pragma unroll
      for (int i = 0; i < 16; ++i) *(f32x4*)(op + (size_t)i * 256) = S[i]; }
    __syncthreads();
    {
        const int t = wid;
        float o[4], ss = 0.f;
#pragma unroll
        for (int e = 0; e < 4; ++e) { o[e] = so[t * 256 + e * 64 + lane]; ss += o[e] * o[e]; }
        const float rstd = rsqrtf(wave_sum(ss) * (1.0f / 256.0f) + EPS);
        const float* nw = C.in[15] + layer * 256;
#pragma unroll
        for (int e = 0; e < 4; ++e) { const int vv = e * 64 + lane; const float z = bf2f(proj[(tokS + t) * ABNP + C_ZB + h * 256 + vv]);
            C.O[(tokS + t) * DM + 1024 + h * 256 + vv] = (bf16)f2bf(o[e] * rstd * nw[vv] * siluf_(z)); }
    }
    __syncthreads();
}

__device__ __forceinline__ void gatenorm_phase(const Ctx& C, int layer, int gwave, int ngw, int lane) {
    const bf16* OA = C.H;
    for (int m = gwave; m < NPT; m += ngw) {
#pragma unroll
        for (int st = 0; st < 4; ++st) {
            const int c0 = st * 512 + lane * 8;
            float o[8], z[8];
            unpack8(*(const v4u*)(OA + (size_t)m * DM + c0), o);
            const bool gdn = st < 2;
            const int zc = gdn ? (C_ZA + c0) : (C_ZB + (c0 - 1024));
            unpack8(*(const v4u*)(C.PROJ + (size_t)m * ABNP + zc), z);
            float ss = 0.f;
#pragma unroll
            for (int e = 0; e < 8; ++e) ss += o[e] * o[e];
            ss += __shfl_xor(ss, 1); ss += __shfl_xor(ss, 2); ss += __shfl_xor(ss, 4); ss += __shfl_xor(ss, 8);
            if (!gdn) ss += __shfl_xor(ss, 16);
            const float rstd = rsqrtf(ss * (gdn ? (1.0f / 128.0f) : (1.0f / 256.0f)) + EPS);
            const float* nw = gdn ? (C.in[12] + layer * 128 + (c0 & 127)) : (C.in[15] + layer * 256 + ((c0 - 1024) & 255));
            const f32x4 n0 = *(const f32x4*)nw, n1 = *(const f32x4*)(nw + 4);
            float r[8];
            r[0] = o[0] * rstd * n0.x * siluf_(z[0]); r[1] = o[1] * rstd * n0.y * siluf_(z[1]); r[2] = o[2] * rstd * n0.z * siluf_(z[2]); r[3] = o[3] * rstd * n0.w * siluf_(z[3]);
            r[4] = o[4] * rstd * n1.x * siluf_(z[4]); r[5] = o[5] * rstd * n1.y * siluf_(z[5]); r[6] = o[6] * rstd * n1.z * siluf_(z[6]); r[7] = o[7] * rstd * n1.w * siluf_(z[7]);
            *(v4u*)(C.O + (size_t)m * DM + c0) = pack8(r);
        }
    }
}

template <int PASS>
__device__ __forceinline__ void lru_item(const Ctx& C, int jl, int item, LAS unsigned char* lds) {
    const int tid = otid(), lane = tid & 63, w = tid >> 6, l15 = lane & 15, quad = lane >> 4;
    const bool sample = item >= 2048;
    const int it2 = sample ? item - 2048 : item;
    const int n = it2 & 15;
    const int chunk = sample ? 0 : (PASS == 3 ? (it2 >> 6) : ((it2 >> 4) & 31)), b = sample ? 0 : (PASS == 3 ? ((it2 >> 4) & 3) : (it2 >> 9)), bg = sample ? (it2 >> 4) : 0;
    const size_t tok0 = sample ? (size_t)NPT + bg * 64 : (size_t)b * TP + chunk * 64;
    LAS float* sXC = (LAS float*)lds;
    LAS float* sAa = sXC + 64 * 132;
    LAS float* sBb = sAa + 64 * 132;
    LAS float* sSegP = sBb + 64 * 132;
    LAS float* sSegH = sSegP + 1024;
    LAS float* sCarry = sSegH + 1024;
    LAS bf16* sXB = (LAS bf16*)(sCarry + 128);
    LAS float* sCP = (LAS float*)(sXB + 64 * 136);
    LAS float* sCH = sCP + 512;
    const bf16* proj = C.PROJ;
    const float* cw = C.in[19] + (size_t)jl * 4 * 2048;
    const int col = tid & 127, sg0 = tid >> 7;
    const int d = w * 16 + l15, chd = n * 128 + d;
    bf16x8 bA[4], bX[4];
#pragma unroll
    for (int kk = 0; kk < 4; ++kk) {
        bA[kk] = *(const bf16x8*)(C.WLA + (size_t)(jl * 16 + n) * 16384 + ((w * 4 + kk) * 64 + lane) * 8);
        bX[kk] = *(const bf16x8*)(C.WLX + (size_t)(jl * 16 + n) * 16384 + ((w * 4 + kk) * 64 + lane) * 8);
    }
    const float ba = C.in[22][jl * 2048 + chd], bx_ = C.in[24][jl * 2048 + chd], lam = C.in[25][jl * 2048 + chd];
    unsigned short gt[16]; float h0[2] = {0.f, 0.f};
    if (PASS >= 2) {
#pragma unroll
        for (int q = 0; q < 2; ++q) {
            const int sgm = sg0 + 4 * q;
#pragma unroll
            for (int r8 = 0; r8 < 8; ++r8) gt[q * 8 + r8] = proj[(tok0 + sgm * 8 + r8) * 4096 + 2048 + n * 128 + col];
            if (sample) h0[q] = C.in[5][(size_t)(jl * 128 + bg * 8 + sgm) * 2048 + n * 128 + col];
        }
    }
    float cP = 1.f, cH = 0.f;
    if (PASS == 2 && !sample) {
        float2 ph[8];
#pragma unroll
        for (int i = 0; i < 8; ++i) { const int cc = sg0 * 8 + i; ph[i] = (cc < chunk) ? *(const float2*)(C.SUM + ((size_t)(b * 32 + cc) * 2048 + n * 128 + col) * 2) : make_float2(1.f, 0.f); }
#pragma unroll
        for (int i = 0; i < 8; ++i) { cH = ph[i].x * cH + ph[i].y; cP *= ph[i].x; }
    }
    v4u xr[2][4];
#pragma unroll
    for (int u = 0; u < 2; ++u) {
        const int idx = tid + u * 512, r = idx >> 4, c8 = (idx & 15) * 8, chn = n * 128 + c8;
#pragma unroll
        for (int j = 0; j < 4; ++j) {
            xr[u][j] = (v4u){0u, 0u, 0u, 0u};
            if (!sample) { const int t = chunk * 64 + r - 3 + j; if (t >= 0) xr[u][j] = *(const v4u*)(proj + ((size_t)b * TP + t) * 4096 + chn); }
            else { const int bb = r >> 3, tl = (r & 7) - 3 + j;
                if (tl >= 0) xr[u][j] = *(const v4u*)(proj + ((size_t)NPT + (bg * 8 + bb) * 8 + tl) * 4096 + chn); }
        }
    }
#pragma unroll
    for (int u = 0; u < 2; ++u) {
        const int idx = tid + u * 512, r = idx >> 4, c8 = (idx & 15) * 8, chn = n * 128 + c8;
        float acc[8];
        { const f32x4 b0 = *(const f32x4*)(C.in[20] + jl * 2048 + chn), b1 = *(const f32x4*)(C.in[20] + jl * 2048 + chn + 4);
          acc[0] = b0.x; acc[1] = b0.y; acc[2] = b0.z; acc[3] = b0.w; acc[4] = b1.x; acc[5] = b1.y; acc[6] = b1.z; acc[7] = b1.w; }
#pragma unroll
        for (int j = 0; j < 4; ++j) {
            float x[8]; unpack8(xr[u][j], x);
            if (sample && j < 3) { const int tl = (r & 7) - 3 + j;
                if (tl < 0) { const float* sp = C.in[6] + ((size_t)(jl * 128 + bg * 8 + (r >> 3)) * 3 + (3 + tl)) * 2048 + chn; const f32x4 h0v = *(const f32x4*)sp, h1v = *(const f32x4*)(sp + 4);
                    x[0] = h0v.x; x[1] = h0v.y; x[2] = h0v.z; x[3] = h0v.w; x[4] = h1v.x; x[5] = h1v.y; x[6] = h1v.z; x[7] = h1v.w; } }
            const f32x4 w0 = *(const f32x4*)(cw + j * 2048 + chn), w1 = *(const f32x4*)(cw + j * 2048 + chn + 4);
            acc[0] += x[0] * w0.x; acc[1] += x[1] * w0.y; acc[2] += x[2] * w0.z; acc[3] += x[3] * w0.w;
            acc[4] += x[4] * w1.x; acc[5] += x[5] * w1.y; acc[6] += x[6] * w1.z; acc[7] += x[7] * w1.w;
            if (PASS >= 2 && j == 3) {
                float* o = nullptr;
                if (!sample) { if (chunk == 31 && r >= 61) o = C.out + O_PLCONV + ((size_t)(jl * 4 + b) * 3 + (r - 61)) * 2048 + chn; }
                else { if ((r & 7) >= 5) o = C.out + O_SLCONV + ((size_t)(jl * 128 + bg * 8 + (r >> 3)) * 3 + ((r & 7) - 5)) * 2048 + chn; }
                if (o) { *(f32x4*)o = (f32x4){x[0], x[1], x[2], x[3]}; *(f32x4*)(o + 4) = (f32x4){x[4], x[5], x[6], x[7]}; }
            }
        }
        *(LAS f32x4*)(sXC + r * 132 + c8) = (f32x4){acc[0], acc[1], acc[2], acc[3]};
        *(LAS f32x4*)(sXC + r * 132 + c8 + 4) = (f32x4){acc[4], acc[5], acc[6], acc[7]};
        *(LAS v4u*)(sXB + r * 136 + c8) = pack8(acc);
    }
    if (PASS == 2 && !sample) { sCP[sg0 * 128 + col] = cP; sCH[sg0 * 128 + col] = cH; }
    __syncthreads();
    if (PASS == 2 && !sample && tid < 128) {
        float hc = 0.f;
#pragma unroll
        for (int q = 0; q < 4; ++q) hc = sCP[q * 128 + tid] * hc + sCH[q * 128 + tid];
        sCarry[tid] = hc;
    }
    {
        f32x4 accA[4], accX[4];
#pragma unroll
        for (int m = 0; m < 4; ++m) { accA[m] = (f32x4){0.f, 0.f, 0.f, 0.f}; accX[m] = accA[m]; }
#pragma unroll
        for (int kk = 0; kk < 4; ++kk) {
#pragma unroll
            for (int m = 0; m < 4; ++m) {
                const bf16x8 a = *(const LAS bf16x8*)(sXB + (m * 16 + l15) * 136 + kk * 32 + quad * 8);
                accA[m] = __builtin_amdgcn_mfma_f32_16x16x32_bf16(a, bA[kk], accA[m], 0, 0, 0);
                accX[m] = __builtin_amdgcn_mfma_f32_16x16x32_bf16(a, bX[kk], accX[m], 0, 0, 0);
            }
        }
        const float sp = softplusf_(-lam);
#pragma unroll
        for (int m = 0; m < 4; ++m)
#pragma unroll
            for (int j = 0; j < 4; ++j) {
                const int row = m * 16 + quad * 4 + j;
                const float rg = sigmoidf_(accA[m][j] + ba), ig = sigmoidf_(accX[m][j] + bx_);
                const float la = -8.0f * rg * sp;
                const float a = __expf(la);
                float mult = sqrtf(fmaxf(1.0f - a * a, 0.f));
                if (!sample && chunk == 0 && row == 0) mult = 1.0f;
                sAa[row * 132 + d] = a; sBb[row * 132 + d] = mult * ig * sXC[row * 132 + d];
            }
    }
    __syncthreads();
#pragma unroll
    for (int q = 0; q < 2; ++q) {
        const int sgm = sg0 + 4 * q;
        float P = 1.f, hh = 0.f;
#pragma unroll
        for (int r8 = 0; r8 < 8; ++r8) { const int row = sgm * 8 + r8; const float a = sAa[row * 132 + col]; hh = a * hh + sBb[row * 132 + col]; P *= a; }
        sSegP[sgm * 128 + col] = P; sSegH[sgm * 128 + col] = hh;
    }
    __syncthreads();
    if (PASS == 3) {
        if (!sample && tid < 128) {
            float P = 1.f, hh = 0.f;
#pragma unroll
            for (int s = 0; s < 8; ++s) { const float ps = sSegP[s * 128 + tid]; hh = ps * hh + sSegH[s * 128 + tid]; P *= ps; }
            unsigned long long* gr = C.CARRY + ((size_t)((jl * 4 + b) * 32 + chunk) * 2048 + n * 128 + tid);
            float cin = 0.f;
            if (chunk > 0) {
                unsigned long long g = 0ull; unsigned spins = 0;
                for (;;) { g = __hip_atomic_load(gr - 2048, __ATOMIC_RELAXED, __HIP_MEMORY_SCOPE_AGENT); if ((unsigned)(g >> 32) == 1u || ++spins > (1u << 20)) break; __builtin_amdgcn_s_sleep(1); }
                cin = __uint_as_float((unsigned)g);
            }
            const float cout = P * cin + hh;
            __hip_atomic_store(gr, (1ull << 32) | (unsigned long long)__float_as_uint(cout), __ATOMIC_RELAXED, __HIP_MEMORY_SCOPE_AGENT);
            sCarry[tid] = cin;
        }
        __syncthreads();
    }
    if (PASS == 1) {
        if (tid < 128) {
            float P = 1.f, hh = 0.f;
#pragma unroll
            for (int s = 0; s < 8; ++s) { const float ps = sSegP[s * 128 + tid]; hh = ps * hh + sSegH[s * 128 + tid]; P *= ps; }
            *(float2*)(C.SUM + ((size_t)(b * 32 + chunk) * 2048 + n * 128 + tid) * 2) = make_float2(P, hh);
        }
    } else {
#pragma unroll
        for (int q = 0; q < 2; ++q) {
            const int sgm = sg0 + 4 * q;
            float hh;
            if (sample) hh = h0[q];
            else { hh = sCarry[col]; for (int s = 0; s < sgm; ++s) hh = sSegP[s * 128 + col] * hh + sSegH[s * 128 + col]; }
#pragma unroll
            for (int r8 = 0; r8 < 8; ++r8) {
                const int row = sgm * 8 + r8;
                hh = sAa[row * 132 + col] * hh + sBb[row * 132 + col];
                const float gate = bf2f(gt[q * 8 + r8]);
                C.O[(tok0 + row) * DM + n * 128 + col] = (bf16)f2bf(hh * siluf_(gate));
            }
            if (sample) C.out[O_SLRU + (size_t)(jl * 128 + bg * 8 + sgm) * 2048 + n * 128 + col] = hh;
            else if (chunk == 31 && sgm == 7) C.out[O_PLRU + (size_t)(jl * 4 + b) * 2048 + n * 128 + col] = hh;
        }
    }
    __syncthreads();
}

#define XB_TMO      128
#define XB_XCNT(j)  (256  + 64 * (j))
#define XB_XSUB(j)  (1280 + 64 * (j))
#define XB_XGEN(j)  (2304 + 64 * (j))
#define XB_TOP      3328
#define XB_TOPGEN   3392
#define XCD_BAR_WORDS 3456
#define XB_SPIN_CAP (1u << 18)

__device__ __forceinline__ unsigned xb_ld(unsigned* p)              { return __hip_atomic_load(p, __ATOMIC_RELAXED, __HIP_MEMORY_SCOPE_AGENT); }
__device__ __forceinline__ unsigned xb_add(unsigned* p, unsigned v) { return __hip_atomic_fetch_add(p, v, __ATOMIC_RELAXED, __HIP_MEMORY_SCOPE_AGENT); }
__device__ __forceinline__ unsigned xb_xcc_id() { return (unsigned)__builtin_amdgcn_s_getreg((3 << 11) | 20) & 0xFu; }
#define XB_SPIN(cond, bar) do { unsigned _sp = 0; while (cond) { __builtin_amdgcn_s_sleep(1); \
    if ((++_sp & 255u) == 0u) { if (xb_ld(&(bar)[XB_TMO])) break; if (_sp > XB_SPIN_CAP) { atomicAdd(&(bar)[XB_TMO], 1u); break; } } } } while (0)

struct XcdBarrier {
    unsigned* bar; unsigned x;
    volatile LAS unsigned* st;
};

__device__ __forceinline__ XcdBarrier xcd_barrier_post(unsigned* bar, volatile LAS unsigned* st) {
    XcdBarrier b; b.bar = bar; b.x = xb_xcc_id(); b.st = st;
    if (threadIdx.x == 0) (void)xb_add(&bar[XB_XCNT(b.x)], 1u);
    return b;
}
__device__ __forceinline__ void xcd_barrier_complete(unsigned* bar, unsigned x, unsigned& nloc, unsigned& nx) {
    const unsigned G = gridDim.x * gridDim.y * gridDim.z;
    unsigned sum, cnt, mine, sp = 0u;
    for (;;) {
        sum = 0u; cnt = 0u; mine = 0u;
#pragma unroll
        for (unsigned j = 0; j < 16; ++j) { const unsigned c = xb_ld(&bar[XB_XCNT(j)]); sum += c; cnt += (c > 0u) ? 1u : 0u; mine = (j == x) ? c : mine; }
        if (sum == G) break;
        __builtin_amdgcn_s_sleep(1);
        if ((++sp & 255u) == 0u) { if (xb_ld(&bar[XB_TMO])) break; if (sp > XB_SPIN_CAP) { atomicAdd(&bar[XB_TMO], 1u); break; } }
    }
    nloc = mine > 0u ? mine : 1u; nx = cnt > 0u ? cnt : 1u;
}

__device__ __forceinline__ void xcd_barrier(const XcdBarrier& b) {
    asm volatile("s_waitcnt vmcnt(0)" ::: "memory");
    __syncthreads();
    if (threadIdx.x == 0) {
        unsigned* bar = b.bar;
        __builtin_amdgcn_s_waitcnt(0);
        unsigned nloc = b.st[0], nx = b.st[1];
        if (nloc == 0u) { xcd_barrier_complete(bar, b.x, nloc, nx); b.st[0] = nloc; b.st[1] = nx; }
        const unsigned old = xb_add(&bar[XB_XSUB(b.x)], 1u);
        const unsigned gen = old / nloc;
        if (old + 1u == (gen + 1u) * nloc) {
            __builtin_amdgcn_fence(__ATOMIC_RELEASE, "agent");
            asm volatile("s_waitcnt vmcnt(0)" ::: "memory");
            const unsigned og = xb_add(&bar[XB_TOP], 1u);
            const unsigned tg = og / nx;
            if (og + 1u == (tg + 1u) * nx) xb_add(&bar[XB_TOPGEN], 1u);
            else XB_SPIN(xb_ld(&bar[XB_TOPGEN]) == tg, bar);
            __builtin_amdgcn_fence(__ATOMIC_ACQUIRE, "agent");
            xb_add(&bar[XB_XGEN(b.x)], 1u);
            asm volatile("s_waitcnt vmcnt(0)" ::: "memory");
        } else {
            XB_SPIN(xb_ld(&bar[XB_XGEN(b.x)]) == gen, bar);
            __builtin_amdgcn_fence(__ATOMIC_ACQUIRE, "agent");
            asm volatile("s_waitcnt vmcnt(0)" ::: "memory");
        }
    }
    __syncthreads();
}

struct OneUnit {
    int pm, pn;
    __device__ bool next(int i, pg8::Unit& u) const { if (i != 0) return false; u.pm = pm; u.pn = pn; return true; }
    __device__ __forceinline__ void a_ready(const pg8::Unit&) const {}
    __device__ __forceinline__ void done(const pg8::Unit&) const {}
};
constexpr int TAB_OFF = 143360;
__device__ __forceinline__ unsigned long long tab_ld(LAS unsigned char* lds, int i) {
    const volatile LAS unsigned* t = (const volatile LAS unsigned*)(lds + TAB_OFF) + 2 * i;
    const unsigned lo = __builtin_amdgcn_readfirstlane(t[0]), hi = __builtin_amdgcn_readfirstlane(t[1]);
    return ((unsigned long long)hi << 32) | lo;
}
__device__ __forceinline__ Ctx make_ctx(LAS unsigned char* lds) {
    Ctx C;
#pragma unroll
    for (int i = 0; i < 28; ++i) C.in[i] = (const float*)tab_ld(lds, i);
    C.out = (float*)tab_ld(lds, 28);
    unsigned char* ws = (unsigned char*)tab_ld(lds, 29);
    C.G = gridDim.x;
    C.WABIN = (bf16*)(ws + WS_WABIN); C.WABOUT = (bf16*)(ws + WS_WABOUT); C.WLIN = (bf16*)(ws + WS_WLIN); C.WLOUT = (bf16*)(ws + WS_WLOUT);
    C.WLA = (bf16*)(ws + WS_WLA); C.WLX = (bf16*)(ws + WS_WLX);
    C.X = (float*)(ws + WS_X); C.H = (bf16*)(ws + WS_H); C.O = (bf16*)(ws + WS_O); C.PROJ = (bf16*)(ws + WS_PROJ);
    C.G_W = (bf16*)(ws + WS_GW); C.G_QG = (bf16*)(ws + WS_GQG); C.G_KDT = (bf16*)(ws + WS_GKDT); C.G_QK = (bf16*)(ws + WS_GQK); C.G_UT = (float*)(ws + WS_GUT);
    C.L_QG = (bf16*)(ws + WS_LQG); C.L_KDT = (bf16*)(ws + WS_LKDT); C.L_A = (bf16*)(ws + WS_LA); C.L_VT = (bf16*)(ws + WS_LVT);
    C.G_DEC = (float*)(ws + WS_GDEC); C.L_DEC = (float*)(ws + WS_LDEC); C.SUM = (float*)(ws + WS_SUM); C.SS = (float*)(ws + 65536); C.CARRY = (unsigned long long*)(ws + WS_CARRY);
    return C;
}
#ifndef TYPE_MASK
#define TYPE_MASK 0xFFFF
#endif
#define TY(t) ((TYPE_MASK >> (t)) & 1)
#ifndef REP_MASK
#define REP_MASK 0
#endif
#define REP(t) for (int rep_ = 0; rep_ < (((REP_MASK >> (t)) & 1) ? 2 : 1); ++rep_)
__global__ void __launch_bounds__(512, 2) mk_fwd(Params p) {
    extern __shared__ __attribute__((aligned(16))) unsigned char lds_raw[];
    LAS unsigned char* lds = (LAS unsigned char*)lds_raw;
    if (threadIdx.x == 0) {
        LAS unsigned long long* t = (LAS unsigned long long*)(lds + TAB_OFF);
#pragma unroll
        for (int i = 0; i < 28; ++i) t[i] = (unsigned long long)p.in[i];
        t[28] = (unsigned long long)p.out; t[29] = (unsigned long long)p.ws;
    }
    if (threadIdx.x < 2) ((LAS unsigned*)(lds + TAB_OFF + 256))[threadIdx.x] = 0u;
    __syncthreads();
    const int lo = p.ph_lo, hi = p.ph_hi;
    const int G = gridDim.x;
    cg::grid_group grid = cg::this_grid();
    XcdBarrier xbar; xbar.bar = (unsigned*)p.ws; xbar.x = 0; xbar.st = nullptr;
    if (hi - lo > 1) xbar = xcd_barrier_post((unsigned*)p.ws, (volatile LAS unsigned*)(lds + TAB_OFF + 256));
#define IN(k) (lo <= (k) && (k) < hi)
#define SEAM2(k, kn) do { if (IN(k) && IN(kn)) { xcd_barrier(xbar); } } while (0)
    if (hi < 0) grid.sync();
#define SEAM(k) do { if (IN(k) && IN((k) + 1)) { xcd_barrier(xbar); } } while (0)
#define GW_DECL const int tid_ = otid(), bid = obid(), lane = tid_ & 63, gw = bid * 8 + (tid_ >> 6), NGW = G * 8

    REP(0) if (TY(0) && IN(0)) { const Ctx C = make_ctx(lds); prologue_phase(C, lds); }
    SEAM(0);
#pragma unroll 1
    for (int l = 0; l < 4; ++l) {
        const int j = l >> 1;
        if ((l & 1) == 0) {
            const int P0 = (l == 0) ? 1 : 12;
            REP(1) if (TY(1) && IN(P0)) {
                const Ctx C = make_ctx(lds); const int bid = obid();
                pg8::Gemm g{C.H, C.WABIN + (size_t)j * ABNP * 2048, NTOK, ABNP, DM}; pg8::StaticOrder S; S.init(NTOK, ABNP, G, bid);
                pg8::EpiProj E{C.PROJ, ABNP, (l == 0) ? (const float*)nullptr : C.SS + (size_t)(l - 1) * NTOK};
                pg8::gemm_phase<pg8::EpiProj, pg8::StaticOrder, true, true>(lds, g, S, E);
                if (l == 0 && G == 256) convert_segment(C, lds, 1, 20);
            }
            SEAM(P0);
            REP(2) if (TY(2) && IN(P0 + 1)) {
                const Ctx C = make_ctx(lds); const int bid = obid();
                for (int it = bid; it < 1536; it += G) { if (it < 1024) gdn_prep_item(C, j, it, lds); else gla_prep_item(C, j, it - 1024, lds); }
            }
            SEAM(P0 + 1);
            REP(3) if (TY(3) && IN(P0 + 2)) {
                const Ctx C = make_ctx(lds); const int bid = obid();
                REP(13) if (G == 256) {
                    const int xcd = bid & 7, slot = bid >> 3;
                    if (slot < 16) scan_task<true>(C, j, (xcd * 4 + (slot >> 2)) * 4 + (slot & 3), lds);
                    else scan_task<false>(C, j, (xcd * 2 + ((slot - 16) >> 3)) * 8 + ((slot - 16) & 7), lds);
                } else
                for (int t = bid; t < 256; t += G) { if (t < 128) scan_task<true>(C, j, t, lds); else scan_task<false>(C, j, t - 128, lds); }
                for (int it = bid; it < 1536; it += G) { if (it < 1024) gdn_sample_item(C, j, it, lds); else gla_sample_item(C, j, it - 1024, lds); }
            }
            SEAM(P0 + 2);
            REP(4) if (TY(4) && IN(P0 + 3)) {
                const Ctx C = make_ctx(lds);
                if (G == 256) {
                    const int bid = obid();
                    if (bid < 32) {
                        const float* resS = (l == 0) ? C.in[1] : C.X + (size_t)NPT * DM;
                        pg8::Gemm g{C.O, C.WABOUT + (size_t)j * 2048 * 2048, NTOK, DM, DM}; OneUnit S1{32 + (bid >> 3), bid & 7};
                        pg8::EpiRes E{C.X, resS, C.X, DM, C.H, C.in[17] + j * DM, C.SS + (size_t)l * NTOK};
                        pg8::gemm_phase<pg8::EpiRes, OneUnit, true, true>(lds, g, S1, E);
                    } else {
                        const int tid_ = otid(), lane = tid_ & 63;
                        gatenorm_phase(C, j, (bid - 32) * 8 + (tid_ >> 6), 224 * 8, lane);
                        if (l == 0) convert_segment(C, lds, 2, 32);
                    }
                } else { GW_DECL; gatenorm_phase(C, j, gw, NGW, lane); }
            }
            SEAM(P0 + 3);
            REP(5) if (TY(5) && IN(P0 + 4)) {
                const Ctx C = make_ctx(lds); const int bid = obid();
                const float* resP = (l == 0) ? C.in[0] : C.X;
                const float* resS = (l == 0) ? C.in[1] : C.X + (size_t)NPT * DM;
                pg8::Gemm g{C.O, C.WABOUT + (size_t)j * 2048 * 2048, NTOK, DM, DM}; pg8::StaticOrder S; S.init((G == 256) ? NPT : NTOK, DM, G, bid);
                pg8::EpiRes E{resP, resS, C.X, DM, C.H, C.in[17] + j * DM, C.SS + (size_t)l * NTOK};
                pg8::gemm_phase<pg8::EpiRes, pg8::StaticOrder, true, true>(lds, g, S, E);
            }
            SEAM2(P0 + 4, P0 + 6);
        } else {
            const int P0 = (l == 1) ? 7 : 18;
            REP(7) if (TY(7) && IN(P0)) {
                const Ctx C = make_ctx(lds); const int bid = obid();
                pg8::Gemm g{C.H, C.WLIN + (size_t)j * 4096 * 2048, NTOK, 4096, DM}; pg8::StaticOrder S; S.init(NTOK, 4096, G, bid);
                pg8::EpiProj E{C.PROJ, 4096, C.SS + (size_t)(l - 1) * NTOK};
                pg8::gemm_phase<pg8::EpiProj, pg8::StaticOrder, true, true>(lds, g, S, E);
                if (l == 1 && G == 256) convert_segment(C, lds, 3, 64);
            }
            SEAM2(P0, P0 + 2);
            REP(9) if (TY(9) && IN(P0 + 2)) { const Ctx C = make_ctx(lds); const int bid = obid(); for (int it = bid; it < 2304; it += G) lru_item<3>(C, j, it, lds); }
            SEAM(P0 + 2);
            REP(10) if (TY(10) && IN(P0 + 3)) {
                const Ctx C = make_ctx(lds); const int bid = obid();
                pg8::Gemm g{C.O, C.WLOUT + (size_t)j * 2048 * 2048, NTOK, DM, DM}; pg8::StaticOrder S; S.init(NTOK, DM, G, bid);
                pg8::EpiRes E{C.X, C.X + (size_t)NPT * DM, C.X, DM, (l == 1) ? C.H : (bf16*)nullptr, C.in[7] + DM, C.SS + (size_t)l * NTOK};
                pg8::gemm_phase<pg8::EpiRes, pg8::StaticOrder, true, true>(lds, g, S, E);
                if (l == 1 && G == 256) convert_segment(C, lds, 4, 32);
            }
            if (l == 1) SEAM2(P0 + 3, P0 + 5); else SEAM(P0 + 3);
            REP(11) if (TY(11) && IN(P0 + 4)) {
                const Ctx C = make_ctx(lds); GW_DECL;
                if (l == 3) rms_phase_f32(C.X, C.in[27], C.out, gw, NGW, lane);
            }
        }
    }
#undef IN
#undef SEAM
}

extern "C" void kernel_launch(void* const* d_in, const int* in_sizes, int n_in, void* d_out, int out_size, void* d_ws, size_t ws_size, hipStream_t stream) {
    static int grid = 0;
    if (grid == 0) {
        if (n_in != 28 || ws_size < WS_END || (size_t)out_size != O_END) { fprintf(stderr, "kernel_launch: unexpected problem (n_in %d, out %d, ws %zu)\n", n_in, out_size, ws_size); grid = -1; return; }
        int dev = 0, cus = 0, per_cu = 0;
        if (hipGetDevice(&dev) != hipSuccess || hipDeviceGetAttribute(&cus, hipDeviceAttributeMultiprocessorCount, dev) != hipSuccess) { grid = -1; return; }
        if (hipFuncSetAttribute((const void*)mk_fwd, hipFuncAttributeMaxDynamicSharedMemorySize, LDS_BYTES) != hipSuccess) { fprintf(stderr, "kernel_launch: hipFuncSetAttribute failed\n"); grid = -1; return; }
        if (hipOccupancyMaxActiveBlocksPerMultiprocessor(&per_cu, (const void*)mk_fwd, 512, LDS_BYTES) != hipSuccess || per_cu < 1) { fprintf(stderr, "kernel_launch: occupancy query says %d\n", per_cu); per_cu = 1; }
        (void)hipGetLastError();
        grid = cus * per_cu;
    }
    if (grid < 0) return;
    if (hipMemsetAsync(d_ws, 0, 262144, stream) != hipSuccess) { fprintf(stderr, "kernel_launch: memset failed\n"); return; }
    if (hipMemsetAsync((char*)d_ws + WS_CARRY, 0, 4 * MiB, stream) != hipSuccess) { fprintf(stderr, "kernel_launch: memset failed\n"); return; }
    Params p{};
    for (int i = 0; i < 28; ++i) p.in[i] = (const float*)d_in[i];
    p.out = (float*)d_out; p.ws = (unsigned char*)d_ws;
#if ONE_LAUNCH
    p.ph_lo = 0; p.ph_hi = NPHASE;
    void* args[] = {&p};
    hipError_t e = hipLaunchCooperativeKernel((const void*)mk_fwd, dim3(grid), dim3(512), args, LDS_BYTES, stream);
    if (e != hipSuccess) fprintf(stderr, "cooperative launch failed: %s (grid %d)\n", hipGetErrorString(e), grid);
#else
    for (int k = 0; k < NPHASE; ++k) {
        p.ph_lo = k; p.ph_hi = k + 1;
        hipLaunchKernelGGL(mk_fwd, dim3(grid), dim3(512), LDS_BYTES, stream, p);
    }
#endif
}
```

```cpp
#include <hip/hip_runtime.h>
#include <hip/hip_cooperative_groups.h>
#include <cstdio>
#include <cstdint>
namespace cg = cooperative_groups;
namespace pg8 {
#define PG8_LAS __attribute__((address_space(3)))
typedef unsigned short bf16_t;
typedef short bf16x8 __attribute__((ext_vector_type(8)));
typedef float f32x4 __attribute__((ext_vector_type(4)));
typedef unsigned u32x4 __attribute__((ext_vector_type(4)));
constexpr int BM = 256, BK = 64, HALF = 128, HTB = HALF * BK * 2  , STAGE_BYTES = 8 * HTB, NXCD = 8, WGM = 8;

__host__ __device__ __forceinline__ int lds_byte(int r, int c) { const int st = (r >> 4) * 2 + (c >> 5), rr = r & 15, cc = c & 31, ob = rr * 64 + cc * 2; return st * 1024 + (ob ^ (((ob >> 9) & 1) << 5)); }
__host__ __device__ __forceinline__ void stage_rc(int b, int& R, int& C) { const int st = b / 1024, sb = b % 1024, swz = sb ^ (((sb >> 9) & 1) << 5); R = (st >> 1) * 16 + swz / 64; C = (st & 1) * 32 + (swz % 64) / 2; }
__host__ __device__ __forceinline__ int perm32(int rho) { const int n = rho >> 4, i = rho & 15; return 8 * (i >> 2) + 4 * n + (i & 3); }

struct Unit { int pm, pn; };
struct Gemm { const bf16_t* A; const bf16_t* Bt; int M, N, K; };

struct StaticOrder {
    int nM, nN, nwg, G, c;
    __host__ __device__ void init(int M, int N, int G_, int c_) { nM = M / BM; nN = N / BM; nwg = nM * nN; G = G_; c = c_; }
    __host__ __device__ bool next(int i, Unit& u) const {
        const long L = (long)i * G + c; if (L >= nwg) return false;
        int wgid = (int)L; { const int q = nwg / NXCD, r = nwg % NXCD, xcd = wgid % NXCD, off = wgid / NXCD; wgid = (xcd < r ? xcd * (q + 1) : r * (q + 1) + (xcd - r) * q) + off; }
        const int nig = WGM * nN, gid = wgid / nig, fm = gid * WGM, gsz = (nM - fm) < WGM ? (nM - fm) : WGM;
        u.pm = fm + ((wgid % nig) % gsz); u.pn = (wgid % nig) / gsz; return true;
    }
    __device__ __forceinline__ void a_ready(const Unit&) const {}
    __device__ __forceinline__ void done(const Unit&) const {}
};

__device__ __forceinline__ unsigned cvt_pk_bf16(float lo, float hi) { unsigned r; asm volatile("v_cvt_pk_bf16_f32 %0, %1, %2" : "=v"(r) : "v"(lo), "v"(hi)); return r; }
typedef float f32x2 __attribute__((ext_vector_type(2)));
struct EpiProj {
    static constexpr bool PERM = true, AFTER_DRAIN = false;
    bf16_t* O; int ldc; const float* ss;
    __device__ __forceinline__ void operator()(const f32x4 (&acc)[2][2][4][2], const Unit& u, int wr, int wc, int fr, int fq) const {
        const int row0 = u.pm * BM + wr * 64 + fr, col0 = u.pn * BM + wc * 32 + 8 * fq;
#pragma unroll
        for (int ai = 0; ai < 2; ++ai)
#pragma unroll
            for (int m = 0; m < 4; ++m) { bf16_t* rowp = O + (size_t)(row0 + ai * HALF + m * 16) * ldc + col0;
                const float rs = ss ? rsqrtf(ss[row0 + ai * HALF + m * 16] * (1.0f / 2048.0f) + 1e-6f) : 1.0f;
#pragma unroll
                for (int bj = 0; bj < 2; ++bj) { const f32x4 v0 = acc[ai][bj][m][0] * rs, v1 = acc[ai][bj][m][1] * rs;
                    u32x4 w; w.x = cvt_pk_bf16(v0[0], v0[1]); w.y = cvt_pk_bf16(v0[2], v0[3]); w.z = cvt_pk_bf16(v1[0], v1[1]); w.w = cvt_pk_bf16(v1[2], v1[3]);
                    *(u32x4*)(rowp + bj * HALF) = w; } }
    }
};
struct EpiRes {
    static constexpr bool PERM = false, AFTER_DRAIN = false;
    const float* baseP; const float* baseS; float* out; int ldc;
    bf16_t* Hn; const float* gn; float* ss;
    __device__ __forceinline__ void operator()(const f32x4 (&acc)[2][2][4][2], const Unit& u, int wr, int wc, int fr, int fq) const {
        const int row0 = u.pm * BM + wr * 64 + fr, col0 = u.pn * BM + wc * 32 + 4 * fq;
        f32x4 g4[2][2];
        if (Hn) {
#pragma unroll
            for (int bj = 0; bj < 2; ++bj)
#pragma unroll
                for (int n = 0; n < 2; ++n) g4[bj][n] = *(const f32x4*)(gn + col0 + bj * HALF + n * 16);
        }
#pragma unroll
        for (int ai = 0; ai < 2; ++ai)
#pragma unroll
            for (int m = 0; m < 4; ++m) { const int row = row0 + ai * HALF + m * 16;
                const float* bp = (row < 8192 ? baseP + (size_t)row * ldc : baseS + (size_t)(row - 8192) * ldc) + col0;
                float* op = out + (size_t)row * ldc + col0;
                float part = 0.f;
#pragma unroll
                for (int bj = 0; bj < 2; ++bj)
#pragma unroll
                    for (int n = 0; n < 2; ++n) { const f32x4 v = *(const f32x4*)(bp + bj * HALF + n * 16) + acc[ai][bj][m][n];
                        *(f32x4*)(op + bj * HALF + n * 16) = v;
                        if (Hn) { part += (v[0] * v[0] + v[1] * v[1]) + (v[2] * v[2] + v[3] * v[3]); const f32x4 gg = g4[bj][n];
                            unsigned w0 = cvt_pk_bf16(v[0] * gg[0], v[1] * gg[1]), w1 = cvt_pk_bf16(v[2] * gg[2], v[3] * gg[3]);
                            typedef unsigned u32x2 __attribute__((ext_vector_type(2)));
                            *(u32x2*)(Hn + (size_t)row * ldc + col0 + bj * HALF + n * 16) = (u32x2){w0, w1}; } }
                if (Hn) { part += __shfl_xor(part, 16); part += __shfl_xor(part, 32); if (fq == 0) unsafeAtomicAdd(ss + row, part); } }
    }
};
template <class Epi, class Sched, bool ALIGN_EPI = false, bool SP2 = false>
__device__ __forceinline__ void gemm_phase(PG8_LAS unsigned char* lds, const Gemm g, const Sched& S, const Epi& E) {
    int tid = threadIdx.x; asm volatile("" : "+v"(tid)); const int wid = __builtin_amdgcn_readfirstlane(tid >> 6), lane = tid & 63, wr = wid >> 2, wc = wid & 3, fr = lane & 15, fq = lane >> 4;
    const int K = g.K, nt = K / BK;
    unsigned voffA[2], voffB[2];
#pragma unroll
    for (int i = 0; i < 2; ++i) { int R, C; stage_rc(tid * 16 + i * 8192, R, C); const int Rb = Epi::PERM ? ((R & ~31) + perm32(R & 31)) : R;
        voffA[i] = (unsigned)(R * K + C) * 2u; voffB[i] = (unsigned)(Rb * K + C) * 2u; }
    const size_t kstep = (size_t)(BK * 2);
    const size_t hstep = (size_t)HALF * K * 2;
    const size_t tstep = 2 * hstep;
    const unsigned ldsw = (unsigned)wid * 1024u;
    const int aoff = lds_byte(wr * 64 + fr, fq * 8), boff = lds_byte(wc * 32 + fr, fq * 8);
#define PG8_SA(b, h) (((b) * 2 + (h)) * HTB)
#define PG8_SB(b, h) ((4 + (b) * 2 + (h)) * HTB)
#define PG8_STAGE(bufoff, gbase, voff) do { _Pragma("unroll") for (int _i = 0; _i < 2; ++_i) \
        __builtin_amdgcn_global_load_lds((const unsigned*)((const char*)(gbase) + (voff)[_i]), (PG8_LAS unsigned*)(lds + (bufoff) + ldsw + _i * 8192), 16, 0, 0); } while (0)
#define PG8_LDA(dst, b, h) do { _Pragma("unroll") for (int m = 0; m < 4; ++m) _Pragma("unroll") for (int k = 0; k < 2; ++k) dst[m][k] = *(const PG8_LAS bf16x8*)(lds + PG8_SA(b, h) + aoff + m * 2048 + k * 1024); } while (0)
#define PG8_LDB(dst, b, h) do { _Pragma("unroll") for (int n = 0; n < 2; ++n) _Pragma("unroll") for (int k = 0; k < 2; ++k) dst[n][k] = *(const PG8_LAS bf16x8*)(lds + PG8_SB(b, h) + boff + n * 2048 + k * 1024); } while (0)
#define PG8_MMA(ai, bj, At, Bt) do { __builtin_amdgcn_s_setprio(1); _Pragma("unroll") for (int m = 0; m < 4; ++m) _Pragma("unroll") for (int n = 0; n < 2; ++n) _Pragma("unroll") for (int k = 0; k < 2; ++k) \
        acc[ai][bj][m][n] = __builtin_amdgcn_mfma_f32_16x16x32_bf16(Bt[n][k], At[m][k], acc[ai][bj][m][n], 0, 0, 0); __builtin_amdgcn_s_setprio(0); } while (0)
#define PG8_WAIT_V(n) asm volatile("s_waitcnt vmcnt(" #n ")" ::: "memory")
#define PG8_WAIT_L(n) asm volatile("s_waitcnt lgkmcnt(" #n ")" ::: "memory")
#define PG8_BAR __builtin_amdgcn_s_barrier()
#define PG8_SCHED __builtin_amdgcn_sched_barrier(0)
    Unit cur, nxt; int ui = 0;
    if (!S.next(0, cur)) return;
    f32x4 acc[2][2][4][2];
#pragma unroll
    for (int a = 0; a < 2; ++a)
#pragma unroll
        for (int b = 0; b < 2; ++b)
#pragma unroll
            for (int m = 0; m < 4; ++m)
#pragma unroll
                for (int n = 0; n < 2; ++n) acc[a][b][m][n] = (f32x4){0.f, 0.f, 0.f, 0.f};
    bf16x8 At[4][2], B0[2][2], B1[2][2];
    const char* cA = (const char*)g.A + (size_t)cur.pm * tstep; const char* cB = (const char*)g.Bt + (size_t)cur.pn * tstep;
    S.a_ready(cur);
    if constexpr (SP2) {
        PG8_STAGE(PG8_SB(0, 0), cB, voffB); PG8_STAGE(PG8_SB(0, 1), cB + hstep, voffB); PG8_STAGE(PG8_SA(0, 0), cA, voffA); PG8_STAGE(PG8_SA(0, 1), cA + hstep, voffA);
        if (wr == 1) PG8_BAR;
        PG8_WAIT_V(2); PG8_BAR;
        PG8_STAGE(PG8_SB(1, 0), cB + kstep, voffB); PG8_STAGE(PG8_SA(1, 0), cA + kstep, voffA); PG8_STAGE(PG8_SB(1, 1), cB + hstep + kstep, voffB);
        PG8_WAIT_V(6); PG8_BAR;
    } else {
        PG8_STAGE(PG8_SB(0, 0), cB, voffB); PG8_STAGE(PG8_SA(0, 0), cA, voffA); PG8_STAGE(PG8_SB(0, 1), cB + hstep, voffB); PG8_STAGE(PG8_SA(0, 1), cA + hstep, voffA);
        if (wr == 1) PG8_BAR;
        PG8_WAIT_V(4); PG8_BAR;
        PG8_STAGE(PG8_SB(1, 0), cB + kstep, voffB); PG8_STAGE(PG8_SA(1, 0), cA + kstep, voffA); PG8_STAGE(PG8_SB(1, 1), cB + hstep + kstep, voffB);
        PG8_WAIT_V(6); PG8_BAR;
    }
    for (;;) {
        const bool has_next = S.next(ui + 1, nxt);
        const char* nA = has_next ? (const char*)g.A + (size_t)nxt.pm * tstep : cA; const char* nB = has_next ? (const char*)g.Bt + (size_t)nxt.pn * tstep : cB;
        for (int t = 0; t < nt; t += 2) {
            const bool last = (t == nt - 2);
            const char* a1 = cA + (size_t)(t + 1) * kstep;
            const char* a2 = last ? nA : cA + (size_t)(t + 2) * kstep; const char* b2 = last ? nB : cB + (size_t)(t + 2) * kstep;
            const char* a3 = a2 + kstep; const char* b3 = b2 + kstep;
            if (last && has_next) S.a_ready(nxt);
            if constexpr (SP2) {
            PG8_LDB(B0, 0, 0); PG8_LDB(B1, 0, 1); PG8_SCHED; PG8_LDA(At, 0, 0); PG8_STAGE(PG8_SA(1, 1), a1 + hstep, voffA);
            PG8_WAIT_V(8); PG8_WAIT_L(0); PG8_BAR; PG8_MMA(0, 0, At, B0); PG8_MMA(0, 1, At, B1); PG8_BAR; PG8_SCHED;
            PG8_LDA(At, 0, 1); PG8_STAGE(PG8_SB(0, 0), b2, voffB); PG8_STAGE(PG8_SB(0, 1), b2 + hstep, voffB); PG8_STAGE(PG8_SA(0, 0), a2, voffA);
            PG8_WAIT_V(8); PG8_WAIT_L(0); PG8_BAR; PG8_MMA(1, 0, At, B0); PG8_MMA(1, 1, At, B1); PG8_BAR; PG8_SCHED;
            PG8_LDB(B0, 1, 0); PG8_LDB(B1, 1, 1); PG8_SCHED; PG8_LDA(At, 1, 0); PG8_STAGE(PG8_SA(0, 1), a2 + hstep, voffA);
            PG8_WAIT_V(8); PG8_WAIT_L(0); PG8_BAR; PG8_MMA(0, 0, At, B0); PG8_MMA(0, 1, At, B1); PG8_BAR; PG8_SCHED;
            PG8_LDA(At, 1, 1); PG8_STAGE(PG8_SB(1, 0), b3, voffB); PG8_STAGE(PG8_SB(1, 1), b3 + hstep, voffB); PG8_STAGE(PG8_SA(1, 0), a3, voffA);
            PG8_WAIT_V(8); PG8_WAIT_L(0); PG8_BAR; PG8_MMA(1, 0, At, B0); PG8_MMA(1, 1, At, B1); PG8_BAR; PG8_SCHED;
            } else {
            PG8_LDB(B0, 0, 0); PG8_SCHED; PG8_LDA(At, 0, 0); PG8_STAGE(PG8_SA(1, 1), a1 + hstep, voffA);
            PG8_WAIT_L(8); PG8_BAR; PG8_WAIT_L(0); PG8_MMA(0, 0, At, B0); PG8_BAR; PG8_SCHED;
            PG8_LDB(B1, 0, 1); PG8_STAGE(PG8_SB(0, 0), b2, voffB);
            PG8_BAR; PG8_WAIT_L(0); PG8_MMA(0, 1, At, B1); PG8_BAR;
            PG8_LDA(At, 0, 1); PG8_STAGE(PG8_SA(0, 0), a2, voffA);
            PG8_BAR; PG8_WAIT_L(0); PG8_MMA(1, 0, At, B0); PG8_BAR; PG8_SCHED;
            PG8_STAGE(PG8_SB(0, 1), b2 + hstep, voffB);
            PG8_WAIT_V(6); PG8_BAR; PG8_MMA(1, 1, At, B1); PG8_BAR;
            PG8_LDB(B0, 1, 0); PG8_SCHED; PG8_LDA(At, 1, 0); PG8_STAGE(PG8_SA(0, 1), a2 + hstep, voffA);
            PG8_WAIT_L(8); PG8_BAR; PG8_WAIT_L(0); PG8_MMA(0, 0, At, B0); PG8_BAR; PG8_SCHED;
            PG8_LDB(B1, 1, 1); PG8_STAGE(PG8_SB(1, 0), b3, voffB);
            PG8_BAR; PG8_WAIT_L(0); PG8_MMA(0, 1, At, B1); PG8_BAR;
            PG8_LDA(At, 1, 1); PG8_STAGE(PG8_SA(1, 0), a3, voffA);
            PG8_BAR; PG8_WAIT_L(0); PG8_MMA(1, 0, At, B0); PG8_BAR; PG8_SCHED;
            PG8_STAGE(PG8_SB(1, 1), b3 + hstep, voffB);
            PG8_WAIT_V(6); PG8_BAR; PG8_MMA(1, 1, At, B1); PG8_BAR;
            }
        }
        if constexpr (ALIGN_EPI) { if (wr == 0) PG8_BAR; }
        if constexpr (!Epi::AFTER_DRAIN) { E(acc, cur, wr, wc, fr, fq); S.done(cur); }
        if (!has_next) break;
#pragma unroll
        for (int a = 0; a < 2; ++a)
#pragma unroll
            for (int b = 0; b < 2; ++b)
#pragma unroll
                for (int m = 0; m < 4; ++m)
#pragma unroll
                    for (int n = 0; n < 2; ++n) acc[a][b][m][n] = (f32x4){0.f, 0.f, 0.f, 0.f};
        cur = nxt; cA = nA; cB = nB; ++ui;
        if constexpr (ALIGN_EPI) { if (wr == 1) PG8_BAR; }
    }
    PG8_WAIT_V(0);
    if constexpr (!ALIGN_EPI) { if (wr == 0) PG8_BAR; }
    PG8_BAR;
    if constexpr (Epi::AFTER_DRAIN) { E.fused(acc, cur, wr, wc, fr, fq, lds, wid, lane); S.done(cur); }
#undef PG8_SA
#undef PG8_SB
#undef PG8_STAGE
#undef PG8_LDA
#undef PG8_LDB
#undef PG8_MMA
#undef PG8_WAIT_V
#undef PG8_WAIT_L
#undef PG8_BAR
#undef PG8_SCHED
}
}

#define LAS __attribute__((address_space(3)))
typedef unsigned short bf16;
typedef unsigned v4u __attribute__((ext_vector_type(4)));
typedef unsigned v2u __attribute__((ext_vector_type(2)));
typedef float f32x4 __attribute__((ext_vector_type(4)));
typedef short bf16x8 __attribute__((ext_vector_type(8)));

#ifndef ONE_LAUNCH
#define ONE_LAUNCH 1
#endif

constexpr int DM = 2048, NTOK = 9216, NPT = 8192, TP = 2048;
constexpr int ABNP = 7424;
constexpr int C_BRAW = 3072, C_ARAW = 3080, C_ZA = 3088, C_QB = 4112, C_KB = 4624, C_VB = 5136, C_LR = 6160, C_ZB = 6176;
constexpr float EPS = 1e-6f;
constexpr int NPHASE = 23;
constexpr int LDS_BYTES = 147456;

constexpr size_t O_YP = 0;
constexpr size_t O_YS = O_YP + (size_t)4 * 2048 * 2048;
constexpr size_t O_PDELTA = O_YS + (size_t)128 * 8 * 2048;
constexpr size_t O_PDCONV = O_PDELTA + (size_t)2 * 4 * 8 * 128 * 128;
constexpr size_t O_PGLA = O_PDCONV + (size_t)2 * 4 * 3 * 3072;
constexpr size_t O_PLRU = O_PGLA + (size_t)2 * 4 * 4 * 128 * 256;
constexpr size_t O_PLCONV = O_PLRU + (size_t)2 * 4 * 2048;
constexpr size_t O_SDELTA = O_PLCONV + (size_t)2 * 4 * 3 * 2048;
constexpr size_t O_SDCONV = O_SDELTA + (size_t)2 * 128 * 8 * 128 * 128;
constexpr size_t O_SGLA = O_SDCONV + (size_t)2 * 128 * 3 * 3072;
constexpr size_t O_SLRU = O_SGLA + (size_t)2 * 128 * 4 * 128 * 256;
constexpr size_t O_SLCONV = O_SLRU + (size_t)2 * 128 * 2048;
constexpr size_t O_END = O_SLCONV + (size_t)2 * 128 * 3 * 2048;
static_assert(O_END == 92676096, "output size");

constexpr size_t MiB = 1u << 20;
constexpr size_t WS_WABIN = 1 * MiB;
constexpr size_t WS_WABOUT = WS_WABIN + 58 * MiB;
constexpr size_t WS_WLIN = WS_WABOUT + 16 * MiB;
constexpr size_t WS_WLOUT = WS_WLIN + 32 * MiB;
constexpr size_t WS_WLA = WS_WLOUT + 16 * MiB;
constexpr size_t WS_WLX = WS_WLA + 1 * MiB;
constexpr size_t WS_X = WS_WLX + 1 * MiB;
constexpr size_t WS_H = WS_X + 72 * MiB;
constexpr size_t WS_O = WS_H + 36 * MiB;
constexpr size_t WS_PROJ = WS_O + 36 * MiB;
constexpr size_t WS_GW = WS_PROJ + 131 * MiB;
constexpr size_t WS_GQG = WS_GW + 16 * MiB;
constexpr size_t WS_GKDT = WS_GQG + 16 * MiB;
constexpr size_t WS_GQK = WS_GKDT + 16 * MiB;
constexpr size_t WS_GUT = WS_GQK + 8 * MiB;
constexpr size_t WS_LQG = WS_GUT + 32 * MiB;
constexpr size_t WS_LKDT = WS_LQG + 8 * MiB;
constexpr size_t WS_LA = WS_LKDT + 8 * MiB;
constexpr size_t WS_LVT = WS_LA + 4 * MiB;
constexpr size_t WS_GDEC = WS_LVT + 16 * MiB;
constexpr size_t WS_LDEC = WS_GDEC + 1 * MiB;
constexpr size_t WS_SUM = WS_LDEC + 1 * MiB;
constexpr size_t WS_CARRY = WS_SUM + 2 * MiB;
constexpr size_t WS_END = WS_CARRY + 4 * MiB;

struct Params { const float* in[28]; float* out; unsigned char* ws; int ph_lo, ph_hi; };

struct Ctx {
    const float* in[28];
    float* out;
    bf16 *WABIN, *WABOUT, *WLIN, *WLOUT, *WLA, *WLX;
    float* X; bf16 *H, *O, *PROJ;
    bf16 *G_W, *G_QG, *G_KDT, *G_QK; float* G_UT;
    bf16 *L_QG, *L_KDT, *L_A, *L_VT; float *G_DEC, *L_DEC, *SUM, *SS; unsigned long long* CARRY;
    int G;
};

__device__ __forceinline__ int otid() { int t = threadIdx.x; asm volatile("" : "+v"(t)); return t; }
__device__ __forceinline__ int obid() { int b = blockIdx.x; asm volatile("" : "+s"(b)); return b; }
__device__ __forceinline__ float bf2f(unsigned b) { return __uint_as_float(b << 16); }
__device__ __forceinline__ unsigned f2bf(float f) { unsigned u = __float_as_uint(f); return (u + 0x7fffu + ((u >> 16) & 1u)) >> 16; }
__device__ __forceinline__ unsigned pk2(float lo, float hi) { return f2bf(lo) | (f2bf(hi) << 16); }
__device__ __forceinline__ void unpack8(v4u w, float (&f)[8]) {
    f[0] = __uint_as_float(w.x << 16); f[1] = __uint_as_float(w.x & 0xffff0000u);
    f[2] = __uint_as_float(w.y << 16); f[3] = __uint_as_float(w.y & 0xffff0000u);
    f[4] = __uint_as_float(w.z << 16); f[5] = __uint_as_float(w.z & 0xffff0000u);
    f[6] = __uint_as_float(w.w << 16); f[7] = __uint_as_float(w.w & 0xffff0000u);
}
__device__ __forceinline__ v4u pack8(const float (&f)[8]) { v4u w; w.x = pk2(f[0], f[1]); w.y = pk2(f[2], f[3]); w.z = pk2(f[4], f[5]); w.w = pk2(f[6], f[7]); return w; }
__device__ __forceinline__ float sigmoidf_(float x) { return __builtin_amdgcn_rcpf(1.0f + __expf(-x)); }
__device__ __forceinline__ float siluf_(float x) { return x * __builtin_amdgcn_rcpf(1.0f + __expf(-x)); }
#define LDS_BARRIER() do { asm volatile("s_waitcnt lgkmcnt(0)" ::: "memory"); __builtin_amdgcn_s_barrier(); asm volatile("" ::: "memory"); } while (0)
__device__ __forceinline__ float softplusf_(float x) { const float e = __expf(fminf(x, 20.f)); const float sp = (e < 0.03f) ? e * (1.0f - e * (0.5f - e * 0.33333333f)) : __logf(1.0f + e); return x > 20.f ? x : sp; }
__device__ __forceinline__ float logsigmoidf_(float x) { return fminf(x, 0.f) - __logf(1.0f + __expf(-fabsf(x))); }
__device__ __forceinline__ float wave_sum(float v) {
#pragma unroll
    for (int o = 1; o < 64; o <<= 1) v += __shfl_xor(v, o);
    return v;
}

__device__ __forceinline__ int frag_off(int row, int col, int nkk) { return (((row >> 4) * nkk + (col >> 5)) * 64 + ((col >> 3) & 3) * 16 + (row & 15)) * 8 + (col & 7); }
__device__ __forceinline__ int ufrag_off(int v, int c) { return (((v >> 4) * 4 + (c >> 4)) * 64 + ((c >> 2) & 3) * 16 + (v & 15)) * 4 + (c & 3); }
template <bool FRAG = false>
__device__ __forceinline__ void transpose_item(const float* W, int K, int N, bf16* WT, LAS float* scr, int item, int lane) {
    const int nblk = N / 32, kb = item / nblk, nb = item % nblk, k0 = 64 * kb, n0 = 32 * nb;
    float tv[32];
#pragma unroll
    for (int i = 0; i < 32; ++i) { const int kk = 2 * i + (lane >> 5); tv[i] = W[(size_t)(k0 + kk) * N + n0 + (lane & 31)]; }
#pragma unroll
    for (int i = 0; i < 32; ++i) { const int kk = 2 * i + (lane >> 5); scr[kk * 33 + (lane & 31)] = tv[i]; }
    asm volatile("s_waitcnt lgkmcnt(0)" ::: "memory");
    const int c = lane & 7;
#pragma unroll
    for (int j = 0; j < 4; ++j) { const int n = (lane >> 3) + 8 * j; const LAS float* s = scr + (8 * c) * 33 + n;
        v4u o; o.x = pk2(s[0 * 33], s[1 * 33]); o.y = pk2(s[2 * 33], s[3 * 33]); o.z = pk2(s[4 * 33], s[5 * 33]); o.w = pk2(s[6 * 33], s[7 * 33]);
        if (FRAG) *(v4u*)(WT + frag_off(n0 + n, k0 + 8 * c, K / 32)) = o;
        else *(v4u*)(WT + (size_t)(n0 + n) * K + k0 + 8 * c) = o; }
    asm volatile("s_waitcnt lgkmcnt(0)" ::: "memory");
}

__device__ __forceinline__ void rms_phase_bf16(const float* baseP, const float* baseS, const float* gw, bf16* Hout, int gwave, int ngw, int lane) {
    for (int m = gwave; m < NTOK; m += ngw) {
        const float* xr = (m < NPT) ? baseP + (size_t)m * DM : baseS + (size_t)(m - NPT) * DM;
        f32x4 v[8]; float ss = 0.f;
#pragma unroll
        for (int j = 0; j < 8; ++j) { v[j] = *(const f32x4*)(xr + (lane + 64 * j) * 4); ss += (v[j].x * v[j].x + v[j].y * v[j].y) + (v[j].z * v[j].z + v[j].w * v[j].w); }
        const float rinv = rsqrtf(wave_sum(ss) * (1.0f / DM) + EPS);
#pragma unroll
        for (int j = 0; j < 8; ++j) { const f32x4 g = *(const f32x4*)(gw + (lane + 64 * j) * 4);
            v2u o; o.x = pk2(v[j].x * rinv * g.x, v[j].y * rinv * g.y); o.y = pk2(v[j].z * rinv * g.z, v[j].w * rinv * g.w);
            *(v2u*)(Hout + (size_t)m * DM + (lane + 64 * j) * 4) = o; }
    }
}
__device__ __forceinline__ void rms_phase_f32(const float* X, const float* gw, float* out, int gwave, int ngw, int lane) {
    for (int m = gwave; m < NTOK; m += ngw) {
        const float* xr = X + (size_t)m * DM;
        f32x4 v[8]; float ss = 0.f;
#pragma unroll
        for (int j = 0; j < 8; ++j) { v[j] = *(const f32x4*)(xr + (lane + 64 * j) * 4); ss += (v[j].x * v[j].x + v[j].y * v[j].y) + (v[j].z * v[j].z + v[j].w * v[j].w); }
        const float rinv = rsqrtf(wave_sum(ss) * (1.0f / DM) + EPS);
#pragma unroll
        for (int j = 0; j < 8; ++j) { const f32x4 g = *(const f32x4*)(gw + (lane + 64 * j) * 4);
            f32x4 o; o.x = v[j].x * rinv * g.x; o.y = v[j].y * rinv * g.y; o.z = v[j].z * rinv * g.z; o.w = v[j].w * rinv * g.w;
            *(f32x4*)(out + (size_t)m * DM + (lane + 64 * j) * 4) = o; }
    }
}

constexpr int I_ABIN = 32 * 225, I_SQ = 32 * 64, I_LIN = 32 * 128, I_BLK = 2 * 4;
constexpr int OFF_ABOUT = 2 * I_ABIN, OFF_LIN = OFF_ABOUT + 2 * I_SQ, OFF_LOUT = OFF_LIN + 2 * I_LIN, OFF_WL = OFF_LOUT + 2 * I_SQ;
__device__ __forceinline__ void convert_item(const Ctx& C, int it, LAS float* scr, int lane) {
    int r = it;
    if (r < 2 * I_ABIN) { const int l = r / I_ABIN; r -= l * I_ABIN; transpose_item(C.in[8] + (size_t)l * 2048 * 7200, 2048, 7200, C.WABIN + (size_t)l * ABNP * 2048, scr, r, lane); return; } r -= 2 * I_ABIN;
    if (r < 2 * I_SQ) { const int l = r / I_SQ; r -= l * I_SQ; transpose_item(C.in[16] + (size_t)l * 2048 * 2048, 2048, 2048, C.WABOUT + (size_t)l * 2048 * 2048, scr, r, lane); return; } r -= 2 * I_SQ;
    if (r < 2 * I_LIN) { const int l = r / I_LIN; r -= l * I_LIN; transpose_item(C.in[18] + (size_t)l * 2048 * 4096, 2048, 4096, C.WLIN + (size_t)l * 4096 * 2048, scr, r, lane); return; } r -= 2 * I_LIN;
    if (r < 2 * I_SQ) { const int l = r / I_SQ; r -= l * I_SQ; transpose_item(C.in[26] + (size_t)l * 2048 * 2048, 2048, 2048, C.WLOUT + (size_t)l * 2048 * 2048, scr, r, lane); return; } r -= 2 * I_SQ;
    { const int which = r / (32 * I_BLK); r -= which * 32 * I_BLK; const int blk = r / I_BLK; r -= blk * I_BLK;
      transpose_item<true>((which ? C.in[23] : C.in[21]) + (size_t)blk * 16384, 128, 128, (which ? C.WLX : C.WLA) + (size_t)blk * 16384, scr, r, lane); }
}
__device__ __forceinline__ void convert_range(const Ctx& C, LAS float* scr, int lo, int hi, int wv, int nw, int lane) {
    if (wv < 0) return;
    for (int it = lo + wv; it < hi; it += nw) convert_item(C, it, scr, lane);
}
__device__ __forceinline__ void convert_segment(const Ctx& C, LAS unsigned char* lds, int seg, int first_idle_block) {
    const int tid = otid(), lane = tid & 63, wave = tid >> 6, bidx = obid();
    if (bidx < first_idle_block) return;
    LAS float* scr = (LAS float*)(lds + wave * 16384);
    const int wv = (bidx - first_idle_block) * 8 + wave, nw = (C.G - first_idle_block) * 8;
    if (seg == 1) {
        convert_range(C, scr, OFF_ABOUT, OFF_ABOUT + I_SQ, wv, nw, lane);
        convert_range(C, scr, OFF_LIN, OFF_LIN + I_LIN, wv, nw, lane);
        convert_range(C, scr, OFF_LOUT, OFF_LOUT + I_SQ, wv, nw, lane);
        convert_range(C, scr, OFF_WL, OFF_WL + 128, wv, nw, lane);
        convert_range(C, scr, OFF_WL + 256, OFF_WL + 384, wv, nw, lane);
    } else if (seg == 2) {
        convert_range(C, scr, I_ABIN, 2 * I_ABIN, wv, nw, lane);
    } else if (seg == 3) {
        convert_range(C, scr, OFF_ABOUT + I_SQ, OFF_ABOUT + 2 * I_SQ, wv, nw, lane);
        convert_range(C, scr, OFF_LIN + I_LIN, OFF_LIN + 2 * I_LIN, wv, nw, lane);
        convert_range(C, scr, OFF_WL + 128, OFF_WL + 256, wv, nw, lane);
        convert_range(C, scr, OFF_WL + 384, OFF_WL + 512, wv, nw, lane);
    } else {
        convert_range(C, scr, OFF_LOUT + I_SQ, OFF_LOUT + 2 * I_SQ, wv, nw, lane);
    }
}
__device__ __forceinline__ void prologue_phase(const Ctx& C, LAS unsigned char* lds) {
    const int tid = otid(), lane = tid & 63, wave = tid >> 6;
    LAS float* scr = (LAS float*)(lds + wave * 16384);
    const int bidx = obid(); const int gw = bidx * 8 + wave, NGW = C.G * 8;
    convert_range(C, scr, 0, (C.G == 256) ? I_ABIN : OFF_WL + 512, gw, NGW, lane);
    { const int gt = bidx * 512 + tid, ngt = C.G * 512; constexpr int PADV = 224 * 2048 / 8;
      for (int i = gt; i < 2 * PADV; i += ngt) { const int l = i / PADV, j = i % PADV; *(v4u*)(C.WABIN + (size_t)l * ABNP * 2048 + (size_t)7200 * 2048 + (size_t)j * 8) = (v4u){0u, 0u, 0u, 0u}; } }
    rms_phase_bf16(C.in[0], C.in[1], C.in[7], C.H, gw, NGW, lane);
}

__device__ __forceinline__ void gdn_prep_item(const Ctx& C, int layer, int item, LAS unsigned char* lds) {
    const int tid = otid(), lane = tid & 63, wid = tid >> 6, l15 = lane & 15, quad = lane >> 4;
    const int n = item & 31, h = (item >> 5) & 7, b = item >> 8;
    const size_t ch = (size_t)n * 32 + (item >> 5);
    LAS float* sQ = (LAS float*)lds;
    LAS float* sK = sQ + 64 * 132;
    LAS float* sV = sK + 64 * 132;
    LAS float* sA = sV + 64 * 132;
    LAS float* sBeta = sA + 64 * 64;
    LAS float* sG = sBeta + 64;
    LAS bf16* sQKb = (LAS bf16*)(sG + 64);
    const bf16* proj = C.PROJ;
    const float* cw = C.in[9] + (size_t)layer * 4 * 3072;
#pragma unroll 2
    for (int idx = tid; idx < 3072; idx += 512) {
        const int r = idx / 48, cg = idx % 48, part = cg >> 4, c8 = (cg & 15) * 8;
        const int col = part * 1024 + h * 128 + c8;
        float acc[8];
#pragma unroll
        for (int e = 0; e < 8; ++e) acc[e] = 0.f;
#pragma unroll
        for (int j = 0; j < 4; ++j) {
            const int t = n * 64 + r - 3 + j;
            if (t >= 0) {
                const v4u w = *(const v4u*)(proj + (size_t)(b * TP + t) * ABNP + col);
                float x[8]; unpack8(w, x);
                const f32x4 w0 = *(const f32x4*)(cw + j * 3072 + col), w1 = *(const f32x4*)(cw + j * 3072 + col + 4);
                acc[0] += x[0] * w0.x; acc[1] += x[1] * w0.y; acc[2] += x[2] * w0.z; acc[3] += x[3] * w0.w;
                acc[4] += x[4] * w1.x; acc[5] += x[5] * w1.y; acc[6] += x[6] * w1.z; acc[7] += x[7] * w1.w;
                if (j == 3 && n == 31 && r >= 61) {
                    float* o = C.out + O_PDCONV + ((size_t)(layer * 4 + b) * 3 + (r - 61)) * 3072 + col;
                    *(f32x4*)o = (f32x4){x[0], x[1], x[2], x[3]}; *(f32x4*)(o + 4) = (f32x4){x[4], x[5], x[6], x[7]};
                }
            }
        }
        LAS float* dst = (part == 0 ? sQ : (part == 1 ? sK : sV)) + r * 132 + c8;
        *(LAS f32x4*)dst = (f32x4){siluf_(acc[0]), siluf_(acc[1]), siluf_(acc[2]), siluf_(acc[3])};
        *(LAS f32x4*)(dst + 4) = (f32x4){siluf_(acc[4]), siluf_(acc[5]), siluf_(acc[6]), siluf_(acc[7])};
    }
    __syncthreads();
#pragma unroll
    for (int rr = 0; rr < 8; ++rr) {
        const int r = wid * 8 + rr;
        { const float a0 = sQ[r * 132 + lane], a1 = sQ[r * 132 + 64 + lane]; const float sc = rsqrtf(wave_sum(a0 * a0 + a1 * a1) + EPS) * 0.08838834764831845f;
          sQ[r * 132 + lane] = a0 * sc; sQ[r * 132 + 64 + lane] = a1 * sc; }
        { const float a0 = sK[r * 132 + lane], a1 = sK[r * 132 + 64 + lane]; const float sc = rsqrtf(wave_sum(a0 * a0 + a1 * a1) + EPS);
          sK[r * 132 + lane] = a0 * sc; sK[r * 132 + 64 + lane] = a1 * sc; }
    }
    if (tid < 64) {
        const size_t row = (size_t)(b * TP + n * 64 + tid);
        const float braw = bf2f(proj[row * ABNP + C_BRAW + h]), araw = bf2f(proj[row * ABNP + C_ARAW + h]);
        const float beta = sigmoidf_(braw);
        float g = -__expf(C.in[10][layer * 8 + h]) * softplusf_(araw + C.in[11][layer * 8 + h]);
#pragma unroll
        for (int o = 1; o < 64; o <<= 1) { const float t = __shfl_up(g, o); if (lane >= o) g += t; }
        sBeta[tid] = beta; sG[tid] = g;
    }
    __syncthreads();
    {
        const int mi = wid >> 1;
#pragma unroll
        for (int tt = 0; tt < 2; ++tt) {
            const int nj = (wid & 1) * 2 + tt;
            f32x4 accA = {0.f, 0.f, 0.f, 0.f}, accQ = {0.f, 0.f, 0.f, 0.f};
            if (nj <= mi) {
#pragma unroll
                for (int k16 = 0; k16 < 8; ++k16) {
                    const f32x4 ka = *(const LAS f32x4*)(sK + (mi * 16 + l15) * 132 + k16 * 16 + quad * 4);
                    const f32x4 qa = *(const LAS f32x4*)(sQ + (mi * 16 + l15) * 132 + k16 * 16 + quad * 4);
                    const f32x4 kb = *(const LAS f32x4*)(sK + (nj * 16 + l15) * 132 + k16 * 16 + quad * 4);
#pragma unroll
                    for (int s = 0; s < 4; ++s) {
                        accA = __builtin_amdgcn_mfma_f32_16x16x4f32(ka[s], kb[s], accA, 0, 0, 0);
                        accQ = __builtin_amdgcn_mfma_f32_16x16x4f32(qa[s], kb[s], accQ, 0, 0, 0);
                    }
                }
            }
            const int j = nj * 16 + l15; const float Gj = sG[j];
            f32x4 av;
#pragma unroll
            for (int jj = 0; jj < 4; ++jj) {
                const int i = mi * 16 + quad * 4 + jj;
                const float dec = (i >= j) ? __expf(sG[i] - Gj) : 0.f;
                av[jj] = (i > j) ? sBeta[i] * accA[jj] * dec : 0.f;
                sQKb[i * 72 + j] = (bf16)f2bf((i >= j) ? accQ[jj] * dec : 0.f);
            }
            if (nj <= mi) *(LAS f32x4*)(sA + j * 64 + mi * 16 + quad * 4) = av;
        }
    }
    __syncthreads();
    {
        const float gl = sG[63];
        for (int idx = tid; idx < 1024; idx += 512) {
            const int r = (idx >> 8) * 16 + (idx & 15), c8 = ((idx >> 6) & 3) * 32 + ((idx >> 4) & 3) * 8; const float eg = __expf(sG[r]);
            float v[8];
#pragma unroll
            for (int e = 0; e < 8; ++e) v[e] = sQ[r * 132 + c8 + e] * eg;
            *(v4u*)(C.G_QG + ch * 8192 + idx * 8) = pack8(v);
        }
        for (int idx = tid; idx < 1024; idx += 512) {
            const int k = (idx >> 7) * 16 + (idx & 15), i8 = ((idx >> 6) & 1) * 32 + ((idx >> 4) & 3) * 8;
            float v[8];
#pragma unroll
            for (int e = 0; e < 8; ++e) v[e] = sK[(i8 + e) * 132 + k] * __expf(gl - sG[i8 + e]);
            *(v4u*)(C.G_KDT + ch * 8192 + idx * 8) = pack8(v);
        }
        { const int idx = tid;
          const int r = (idx >> 7) * 16 + (idx & 15), c8 = ((idx >> 6) & 1) * 32 + ((idx >> 4) & 3) * 8;
          *(v4u*)(C.G_QK + ch * 4096 + idx * 8) = *(const LAS v4u*)(sQKb + r * 72 + c8); }
        if (tid == 0) C.G_DEC[ch] = __expf(gl);
    }
    __syncthreads();
    if (tid < 256) {
        const int c = tid;
        LAS float* colp = (c < 128) ? (sV + c) : (sK + (c - 128));
#pragma unroll 1
        for (int I = 0; I < 4; ++I) {
            float sl[16];
#pragma unroll
            for (int ii = 0; ii < 16; ++ii) { const int i = I * 16 + ii; const float f = (c < 128) ? sBeta[i] : sBeta[i] * __expf(sG[i]); sl[ii] = colp[i * 132] * f; }
#pragma unroll 4
            for (int j = 0; j < I * 16; ++j) {
                const float x = colp[j * 132];
                const LAS float* ap = sA + j * 64 + I * 16;
                const f32x4 a0 = *(const LAS f32x4*)ap, a1 = *(const LAS f32x4*)(ap + 4), a2 = *(const LAS f32x4*)(ap + 8), a3 = *(const LAS f32x4*)(ap + 12);
                sl[0] -= a0.x * x; sl[1] -= a0.y * x; sl[2] -= a0.z * x; sl[3] -= a0.w * x;
                sl[4] -= a1.x * x; sl[5] -= a1.y * x; sl[6] -= a1.z * x; sl[7] -= a1.w * x;
                sl[8] -= a2.x * x; sl[9] -= a2.y * x; sl[10] -= a2.z * x; sl[11] -= a2.w * x;
                sl[12] -= a3.x * x; sl[13] -= a3.y * x; sl[14] -= a3.z * x; sl[15] -= a3.w * x;
            }
#pragma unroll
            for (int jj = 0; jj < 15; ++jj) {
                const LAS float* ap = sA + (I * 16 + jj) * 64 + I * 16;
                float a[16];
#pragma unroll
                for (int q4 = 0; q4 < 4; ++q4) { const f32x4 t = *(const LAS f32x4*)(ap + q4 * 4); a[q4 * 4] = t.x; a[q4 * 4 + 1] = t.y; a[q4 * 4 + 2] = t.z; a[q4 * 4 + 3] = t.w; }
#pragma unroll
                for (int ii = jj + 1; ii < 16; ++ii) sl[ii] -= a[ii] * sl[jj];
            }
#pragma unroll
            for (int ii = 0; ii < 16; ++ii) colp[(I * 16 + ii) * 132] = sl[ii];
        }
    }
    __syncthreads();
    for (int idx = tid; idx < 1024; idx += 512) {
        const int r = (idx >> 8) * 16 + (idx & 15), c8 = ((idx >> 6) & 3) * 32 + ((idx >> 4) & 3) * 8;
        float v[8];
#pragma unroll
        for (int e = 0; e < 8; ++e) v[e] = sK[r * 132 + c8 + e];
        *(v4u*)(C.G_W + ch * 8192 + idx * 8) = pack8(v);
    }
    for (int idx = tid; idx < 2048; idx += 512) {
        const int v = (idx >> 8) * 16 + (idx & 15), c = ((idx >> 6) & 3) * 16 + ((idx >> 4) & 3) * 4;
        *(f32x4*)(C.G_UT + ch * 8192 + idx * 4) = (f32x4){sV[c * 132 + v], sV[(c + 1) * 132 + v], sV[(c + 2) * 132 + v], sV[(c + 3) * 132 + v]};
    }
    __syncthreads();
}

__device__ __forceinline__ void gla_prep_item(const Ctx& C, int layer, int item, LAS unsigned char* lds) {
    const int tid = otid(), lane = tid & 63, wid = tid >> 6, l15 = lane & 15, quad = lane >> 4;
    const int n = item & 31, h = (item >> 5) & 3, b = item >> 7;
    const size_t ch = (size_t)n * 16 + (item >> 5);
    const size_t tok0 = (size_t)b * TP + n * 64;
    LAS float* sQG = (LAS float*)lds;
    LAS float* sKN = sQG + 64 * 132;
    LAS float* sBc = sKN + 64 * 132;
    LAS float* sLR = sBc + 64 * 132;
    LAS bf16* sAb = (LAS bf16*)(sLR + 1024);
    const bf16* proj = C.PROJ;
    for (int idx = tid; idx < 1024; idx += 512) { const int r = idx >> 4, m = idx & 15; sLR[idx] = bf2f(proj[(tok0 + r) * ABNP + C_LR + m]); }
    __syncthreads();
    {
        const int k = tid & 127, rg = tid >> 7;
        float wl[16];
#pragma unroll
        for (int m = 0; m < 16; ++m) wl[m] = C.in[13][(size_t)(layer * 16 + m) * 512 + h * 128 + k];
        const float bl = C.in[14][layer * 512 + h * 128 + k];
        for (int r = rg * 16; r < rg * 16 + 16; ++r) {
            float x = bl;
#pragma unroll
            for (int m = 0; m < 16; ++m) x += sLR[r * 16 + m] * wl[m];
            sBc[r * 132 + k] = logsigmoidf_(x) * (1.0f / 16.0f);
        }
    }
    __syncthreads();
    if (tid < 128) { float acc = 0.f;
#pragma unroll 16
        for (int r = 0; r < 64; ++r) { acc += sBc[r * 132 + tid]; sBc[r * 132 + tid] = acc; } }
    __syncthreads();
    for (int idx = tid; idx < 1024; idx += 512) {
        const int r = idx >> 4, c8 = (idx & 15) * 8;
        float q[8], k[8], qg[8];
        unpack8(*(const v4u*)(proj + (tok0 + r) * ABNP + C_QB + h * 128 + c8), q);
        unpack8(*(const v4u*)(proj + (tok0 + r) * ABNP + C_KB + h * 128 + c8), k);
#pragma unroll
        for (int e = 0; e < 8; ++e) { const float bc = sBc[r * 132 + c8 + e]; qg[e] = q[e] * 0.08838834764831845f * __expf(bc); sQG[r * 132 + c8 + e] = qg[e]; sKN[r * 132 + c8 + e] = k[e] * __expf(-bc); }
    }
    for (int idx = tid; idx < 2048; idx += 512) {
        const int v = idx & 255, i8 = (idx >> 8) * 8;
        float x[8];
#pragma unroll
        for (int e = 0; e < 8; ++e) x[e] = bf2f(proj[(tok0 + i8 + e) * ABNP + C_VB + h * 256 + v]);
        *(v4u*)(C.L_VT + ch * 16384 + frag_off(v, i8, 2)) = pack8(x);
    }
    __syncthreads();
    for (int idx = tid; idx < 1024; idx += 512) {
        const int r = (idx >> 8) * 16 + (idx & 15), c8 = ((idx >> 6) & 3) * 32 + ((idx >> 4) & 3) * 8;
        float v[8];
#pragma unroll
        for (int e = 0; e < 8; ++e) v[e] = sQG[r * 132 + c8 + e];
        *(v4u*)(C.L_QG + ch * 8192 + idx * 8) = pack8(v);
    }
    for (int idx = tid; idx < 1024; idx += 512) {
        const int k = (idx >> 7) * 16 + (idx & 15), i8 = ((idx >> 6) & 1) * 32 + ((idx >> 4) & 3) * 8; const float ebl = __expf(sBc[63 * 132 + k]);
        float v[8];
#pragma unroll
        for (int e = 0; e < 8; ++e) v[e] = sKN[(i8 + e) * 132 + k] * ebl;
        *(v4u*)(C.L_KDT + ch * 8192 + idx * 8) = pack8(v);
    }
    if (tid < 128) C.L_DEC[ch * 128 + tid] = __expf(sBc[63 * 132 + tid]);
    {
        const int mi = wid >> 1;
#pragma unroll
        for (int tt = 0; tt < 2; ++tt) {
            const int nj = (wid & 1) * 2 + tt;
            f32x4 acc = {0.f, 0.f, 0.f, 0.f};
            if (nj <= mi) {
#pragma unroll
                for (int k16 = 0; k16 < 8; ++k16) {
                    const f32x4 qa = *(const LAS f32x4*)(sQG + (mi * 16 + l15) * 132 + k16 * 16 + quad * 4);
                    const f32x4 kb = *(const LAS f32x4*)(sKN + (nj * 16 + l15) * 132 + k16 * 16 + quad * 4);
#pragma unroll
                    for (int s = 0; s < 4; ++s) acc = __builtin_amdgcn_mfma_f32_16x16x4f32(qa[s], kb[s], acc, 0, 0, 0);
                }
            }
            const int j = nj * 16 + l15;
#pragma unroll
            for (int jj = 0; jj < 4; ++jj) { const int i = mi * 16 + quad * 4 + jj; sAb[i * 72 + j] = (bf16)f2bf((i >= j) ? acc[jj] : 0.f); }
        }
    }
    __syncthreads();
    { const int idx = tid;
      const int r = (idx >> 7) * 16 + (idx & 15), c8 = ((idx >> 6) & 1) * 32 + ((idx >> 4) & 3) * 8;
      *(v4u*)(C.L_A + ch * 4096 + idx * 8) = *(const LAS v4u*)(sAb + r * 72 + c8); }
    __syncthreads();
}

template <bool HAS_W> struct ScanFr { bf16x8 aq[4]; bf16x8 aw[4]; bf16x8 aqk[2]; bf16x8 ak[2][2]; bf16x8 bvg[2]; f32x4 u; f32x4 dec[2]; };
template <bool HAS_W>
__device__ __forceinline__ void scan_load(ScanFr<HAS_W>& F, const Ctx& C, size_t ch, int s, int mi, int ni, int kt0, int l15, int quad) {
    const int lane8 = (quad * 16 + l15) * 8;
    const bf16* QG = (HAS_W ? C.G_QG : C.L_QG) + ch * 8192 + lane8;
    const bf16* KDT = (HAS_W ? C.G_KDT : C.L_KDT) + ch * 8192 + lane8;
    const bf16* QK = (HAS_W ? C.G_QK : C.L_A) + ch * 4096 + lane8;
#pragma unroll
    for (int kk = 0; kk < 4; ++kk) {
        F.aq[kk] = *(const bf16x8*)(QG + (mi * 4 + kk) * 512);
        if (HAS_W) F.aw[kk] = *(const bf16x8*)(C.G_W + ch * 8192 + lane8 + (mi * 4 + kk) * 512);
    }
#pragma unroll
    for (int kk = 0; kk < 2; ++kk) {
        F.aqk[kk] = *(const bf16x8*)(QK + (mi * 2 + kk) * 512);
#pragma unroll
        for (int t = 0; t < 2; ++t) F.ak[t][kk] = *(const bf16x8*)(KDT + ((kt0 + t) * 2 + kk) * 512);
        if (!HAS_W) F.bvg[kk] = *(const bf16x8*)(C.L_VT + ch * 16384 + lane8 + ((s * 2 + ni) * 2 + kk) * 512);
    }
    if (HAS_W) {
        F.u = *(const f32x4*)(C.G_UT + ch * 8192 + (((s * 2 + ni) * 4 + mi) * 64 + quad * 16 + l15) * 4);
        const float d = C.G_DEC[ch]; F.dec[0] = (f32x4){d, d, d, d}; F.dec[1] = F.dec[0];
    } else {
#pragma unroll
        for (int t = 0; t < 2; ++t) F.dec[t] = *(const f32x4*)(C.L_DEC + ch * 128 + (kt0 + t) * 16 + quad * 4);
    }
}
template <bool HAS_W>
__device__ __forceinline__ void scan_step(const ScanFr<HAS_W>& F, f32x4 (&Sacc)[2], LAS bf16* sST, LAS bf16* sVT, LAS bf16* sO, int mi, int ni, int kt0, int l15, int quad) {
    f32x4 acc_o = {0.f, 0.f, 0.f, 0.f}, acc_w = {0.f, 0.f, 0.f, 0.f};
#pragma unroll
    for (int kk = 0; kk < 4; ++kk) {
        const bf16x8 bfr = *(const LAS bf16x8*)(sST + (ni * 16 + l15) * 136 + kk * 32 + quad * 8);
        acc_o = __builtin_amdgcn_mfma_f32_16x16x32_bf16(F.aq[kk], bfr, acc_o, 0, 0, 0);
        if (HAS_W) acc_w = __builtin_amdgcn_mfma_f32_16x16x32_bf16(F.aw[kk], bfr, acc_w, 0, 0, 0);
    }
    if (HAS_W) {
        const f32x4 vn = F.u - acc_w;
        v2u o; o.x = pk2(vn.x, vn.y); o.y = pk2(vn.z, vn.w);
        *(LAS v2u*)(sVT + (ni * 16 + l15) * 72 + mi * 16 + quad * 4) = o;
    }
    LDS_BARRIER();
    bf16x8 bv[2];
#pragma unroll
    for (int kk = 0; kk < 2; ++kk) {
        if (HAS_W) bv[kk] = *(const LAS bf16x8*)(sVT + (ni * 16 + l15) * 72 + kk * 32 + quad * 8);
        else bv[kk] = F.bvg[kk];
    }
#pragma unroll
    for (int kk = 0; kk < 2; ++kk) acc_o = __builtin_amdgcn_mfma_f32_16x16x32_bf16(F.aqk[kk], bv[kk], acc_o, 0, 0, 0);
#pragma unroll
    for (int j = 0; j < 4; ++j) sO[(mi * 16 + quad * 4 + j) * 40 + ni * 16 + l15] = (bf16)f2bf(acc_o[j]);
#pragma unroll
    for (int t = 0; t < 2; ++t) {
        Sacc[t] = Sacc[t] * F.dec[t];
#pragma unroll
        for (int kk = 0; kk < 2; ++kk) Sacc[t] = __builtin_amdgcn_mfma_f32_16x16x32_bf16(F.ak[t][kk], bv[kk], Sacc[t], 0, 0, 0);
        v2u o; o.x = pk2(Sacc[t].x, Sacc[t].y); o.y = pk2(Sacc[t].z, Sacc[t].w);
        *(LAS v2u*)(sST + (ni * 16 + l15) * 136 + (kt0 + t) * 16 + quad * 4) = o;
    }
    LDS_BARRIER();
}
template <bool HAS_W>
__device__ __forceinline__ void scan_task(const Ctx& C, int layer, int task, LAS unsigned char* lds) {
    const int tid = otid(), lane = tid & 63, w = tid >> 6, l15 = lane & 15, quad = lane >> 4;
    const int s = HAS_W ? (task & 3) : (task & 7), bh = HAS_W ? (task >> 2) : (task >> 3);
    const int b = HAS_W ? (bh >> 3) : (bh >> 2), h = HAS_W ? (bh & 7) : (bh & 3);
    const int mi = w >> 1, ni = w & 1, kt0 = (w >> 1) * 2;
    LAS bf16* sST = (LAS bf16*)lds;
    LAS bf16* sVT = sST + 32 * 136;
    LAS bf16* sO = sVT + 32 * 72;
    f32x4 Sacc[2]; Sacc[0] = (f32x4){0.f, 0.f, 0.f, 0.f}; Sacc[1] = Sacc[0];
    for (int i = tid; i < 32 * 136 / 2; i += 512) ((LAS unsigned*)sST)[i] = 0u;
    const int colbase = HAS_W ? (h * 128 + s * 32) : (1024 + h * 256 + s * 32);
    bf16* OA = C.H + (size_t)b * TP * DM + colbase;
    const int NBH = HAS_W ? 32 : 16;
    ScanFr<HAS_W> FA, FB;
    __syncthreads();
#pragma unroll 1
    for (int n = 0; n < 32; n += 2) {
        scan_load<HAS_W>(FA, C, (size_t)n * NBH + bh, s, mi, ni, kt0, l15, quad);
        scan_load<HAS_W>(FB, C, (size_t)(n + 1) * NBH + bh, s, mi, ni, kt0, l15, quad);
        scan_step<HAS_W>(FA, Sacc, sST, sVT, sO, mi, ni, kt0, l15, quad);
        scan_step<HAS_W>(FB, Sacc, sST, sVT, sO + 64 * 40, mi, ni, kt0, l15, quad);
        {
            const int r = tid >> 2, sgm = tid & 3;
            const v4u ov = *(const LAS v4u*)(sO + r * 40 + sgm * 8);
            *(v4u*)(OA + (size_t)(n * 64 + r) * DM + sgm * 8) = ov;
        }
    }
    const int DV = HAS_W ? 128 : 256;
    float* outS = C.out + (HAS_W ? O_PDELTA + (size_t)((layer * 4 + b) * 8 + h) * 128 * 128 : O_PGLA + (size_t)((layer * 4 + b) * 4 + h) * 128 * 256);
#pragma unroll
    for (int t = 0; t < 2; ++t)
#pragma unroll
        for (int j = 0; j < 4; ++j) outS[(size_t)((kt0 + t) * 16 + quad * 4 + j) * DV + s * 32 + ni * 16 + l15] = Sacc[t][j];
    __syncthreads();
}

__device__ __forceinline__ void gdn_sample_item(const Ctx& C, int layer, int item, LAS unsigned char* lds) {
    const int tid = otid(), lane = tid & 63, wid = tid >> 6;
    const int h = item & 7, b = item >> 3;
    LAS float* sq = (LAS float*)lds;
    LAS float* sk = sq + 1024;
    LAS float* sv = sk + 1024;
    LAS float* so = sv + 1024;
    LAS float* red = so + 1024;
    LAS float* red2 = red + 512;
    LAS float* sbeta = red2 + 512;
    LAS float* seg = sbeta + 8;
    const bf16* proj = C.PROJ;
    const size_t tokS = (size_t)NPT + b * 8;
    const float* cw = C.in[9] + (size_t)layer * 4 * 3072;
    if (tid < 384) {
        const int t = tid / 48, cg = tid % 48, part = cg >> 4, c8 = (cg & 15) * 8;
        const int col = part * 1024 + h * 128 + c8;
        float acc[8];
#pragma unroll
        for (int e = 0; e < 8; ++e) acc[e] = 0.f;
#pragma unroll
        for (int j = 0; j < 4; ++j) {
            const int tl = t - 3 + j;
            float x[8];
            if (tl >= 0) unpack8(*(const v4u*)(proj + (tokS + tl) * ABNP + col), x);
            else { const float* sp = C.in[3] + ((size_t)(layer * 128 + b) * 3 + (3 + tl)) * 3072 + col;
                const f32x4 a = *(const f32x4*)sp, c = *(const f32x4*)(sp + 4); x[0] = a.x; x[1] = a.y; x[2] = a.z; x[3] = a.w; x[4] = c.x; x[5] = c.y; x[6] = c.z; x[7] = c.w; }
            const f32x4 w0 = *(const f32x4*)(cw + j * 3072 + col), w1 = *(const f32x4*)(cw + j * 3072 + col + 4);
            acc[0] += x[0] * w0.x; acc[1] += x[1] * w0.y; acc[2] += x[2] * w0.z; acc[3] += x[3] * w0.w;
            acc[4] += x[4] * w1.x; acc[5] += x[5] * w1.y; acc[6] += x[6] * w1.z; acc[7] += x[7] * w1.w;
            if (j == 3 && t >= 5) {
                float* o = C.out + O_SDCONV + ((size_t)(layer * 128 + b) * 3 + (t - 5)) * 3072 + col;
                *(f32x4*)o = (f32x4){x[0], x[1], x[2], x[3]}; *(f32x4*)(o + 4) = (f32x4){x[4], x[5], x[6], x[7]};
            }
        }
        LAS float* dst = (part == 0 ? sq : (part == 1 ? sk : sv)) + t * 128 + c8;
        *(LAS f32x4*)dst = (f32x4){siluf_(acc[0]), siluf_(acc[1]), siluf_(acc[2]), siluf_(acc[3])};
        *(LAS f32x4*)(dst + 4) = (f32x4){siluf_(acc[4]), siluf_(acc[5]), siluf_(acc[6]), siluf_(acc[7])};
    }
    __syncthreads();
    {
        const int r = wid;
        { const float a0 = sq[r * 128 + lane], a1 = sq[r * 128 + 64 + lane]; const float sc = rsqrtf(wave_sum(a0 * a0 + a1 * a1) + EPS) * 0.08838834764831845f;
          sq[r * 128 + lane] = a0 * sc; sq[r * 128 + 64 + lane] = a1 * sc; }
        { const float a0 = sk[r * 128 + lane], a1 = sk[r * 128 + 64 + lane]; const float sc = rsqrtf(wave_sum(a0 * a0 + a1 * a1) + EPS);
          sk[r * 128 + lane] = a0 * sc; sk[r * 128 + 64 + lane] = a1 * sc; }
        if (tid < 8) {
            const float braw = bf2f(proj[(tokS + tid) * ABNP + C_BRAW + h]), araw = bf2f(proj[(tokS + tid) * ABNP + C_ARAW + h]);
            sbeta[tid] = sigmoidf_(braw);
            seg[tid] = __expf(-__expf(C.in[10][layer * 8 + h]) * softplusf_(araw + C.in[11][layer * 8 + h]));
        }
    }
    const int v = tid & 127, kg = tid >> 7;
    float S[32];
    { const float* sp = C.in[2] + ((size_t)((layer * 128 + b) * 8 + h) * 128 + kg * 32) * 128 + v;
#pragma unroll
      for (int i = 0; i < 32; ++i) S[i] = sp[(size_t)i * 128]; }
    __syncthreads();
    for (int t = 0; t < 8; ++t) {
        const float eg = seg[t];
        float p = 0.f;
#pragma unroll
        for (int i = 0; i < 32; ++i) p += S[i] * sk[t * 128 + kg * 32 + i];
        red[kg * 128 + v] = p;
        __syncthreads();
        const float r = (red[v] + red[128 + v]) + (red[256 + v] + red[384 + v]);
        const float vn = sbeta[t] * (sv[t * 128 + v] - eg * r);
        float po = 0.f;
#pragma unroll
        for (int i = 0; i < 32; ++i) { S[i] = eg * S[i] + sk[t * 128 + kg * 32 + i] * vn; po += S[i] * sq[t * 128 + kg * 32 + i]; }
        red2[kg * 128 + v] = po;
        __syncthreads();
        if (kg == 0) so[t * 128 + v] = (red2[v] + red2[128 + v]) + (red2[256 + v] + red2[384 + v]);
    }
    { float* op = C.out + O_SDELTA + ((size_t)((layer * 128 + b) * 8 + h) * 128 + kg * 32) * 128 + v;
#pragma unroll
      for (int i = 0; i < 32; ++i) op[(size_t)i * 128] = S[i]; }
    __syncthreads();
    {
        const int t = wid;
        const float o0 = so[t * 128 + lane], o1 = so[t * 128 + 64 + lane];
        const float rstd = rsqrtf(wave_sum(o0 * o0 + o1 * o1) * (1.0f / 128.0f) + EPS);
        const float* nw = C.in[12] + layer * 128;
        const float z0 = bf2f(proj[(tokS + t) * ABNP + C_ZA + h * 128 + lane]), z1 = bf2f(proj[(tokS + t) * ABNP + C_ZA + h * 128 + 64 + lane]);
        C.O[(tokS + t) * DM + h * 128 + lane] = (bf16)f2bf(o0 * rstd * nw[lane] * siluf_(z0));
        C.O[(tokS + t) * DM + h * 128 + 64 + lane] = (bf16)f2bf(o1 * rstd * nw[64 + lane] * siluf_(z1));
    }
    __syncthreads();
}

__device__ __forceinline__ void gla_sample_item(const Ctx& C, int layer, int item, LAS unsigned char* lds) {
    const int tid = otid(), lane = tid & 63, wid = tid >> 6;
    const int h = item & 3, b = item >> 2;
    LAS float* sq = (LAS float*)lds;
    LAS float* sk = sq + 1024;
    LAS float* sgk = sk + 1024;
    LAS float* sv = sgk + 1024;
    LAS float* so = sv + 2048;
    LAS float* red = so + 2048;
    LAS float* slr = red + 4096;
    const bf16* proj = C.PROJ;
    const size_t tokS = (size_t)NPT + b * 8;
    if (tid < 128) slr[tid] = bf2f(proj[(tokS + (tid >> 4)) * ABNP + C_LR + (tid & 15)]);
    for (int idx = tid; idx < 1024; idx += 512) { const int t = idx >> 7, k = idx & 127;
        sq[idx] = bf2f(proj[(tokS + t) * ABNP + C_QB + h * 128 + k]) * 0.08838834764831845f; sk[idx] = bf2f(proj[(tokS + t) * ABNP + C_KB + h * 128 + k]); }
    for (int idx = tid; idx < 2048; idx += 512) { const int t = idx >> 8, vv = idx & 255; sv[idx] = bf2f(proj[(tokS + t) * ABNP + C_VB + h * 256 + vv]); }
    __syncthreads();
    for (int idx = tid; idx < 1024; idx += 512) { const int t = idx >> 7, k = idx & 127;
        float x = C.in[14][layer * 512 + h * 128 + k];
#pragma unroll
        for (int m = 0; m < 16; ++m) x += slr[t * 16 + m] * C.in[13][(size_t)(layer * 16 + m) * 512 + h * 128 + k];
        sgk[idx] = __expf(logsigmoidf_(x) * (1.0f / 16.0f)); }
    const int v4 = (tid & 63) * 4, k0 = (tid >> 6) * 16;
    f32x4 S[16];
    { const float* sp = C.in[4] + ((size_t)((layer * 128 + b) * 4 + h) * 128 + k0) * 256 + v4;
#pragma unroll
      for (int i = 0; i < 16; ++i) S[i] = *(const f32x4*)(sp + (size_t)i * 256); }
    __syncthreads();
    LAS float* red8 = red;
    for (int t = 0; t < 8; ++t) {
        const f32x4 vt = *(const LAS f32x4*)(sv + t * 256 + v4);
        f32x4 po = {0.f, 0.f, 0.f, 0.f};
#pragma unroll
        for (int i4 = 0; i4 < 4; ++i4) {
            const f32x4 g4 = *(const LAS f32x4*)(sgk + t * 128 + k0 + i4 * 4), kk4 = *(const LAS f32x4*)(sk + t * 128 + k0 + i4 * 4), q4 = *(const LAS f32x4*)(sq + t * 128 + k0 + i4 * 4);
#pragma unroll
            for (int e = 0; e < 4; ++e) { const int i = i4 * 4 + e; S[i] = S[i] * g4[e] + vt * kk4[e]; po = po + S[i] * q4[e]; }
        }
        *(LAS f32x4*)(red8 + (t & 1) * 2048 + (tid >> 6) * 256 + v4) = po;
        __syncthreads();
        if (tid < 256) { float a = 0.f;
#pragma unroll
            for (int g = 0; g < 8; ++g) a += red8[(t & 1) * 2048 + g * 256 + tid];
            so[t * 256 + tid] = a; }
    }
    { float* op = C.out + O_SGLA + ((size_t)((layer * 128 + b) * 4 + h) * 128 + k0) * 256 + v4;
#pragma unroll
      for (int i = 0; i < 16; ++i) *(f32x4*)(op + (size_t)i * 256) = S[i]; }
    __syncthreads();
    {
        const int t = wid;
        float o[4], ss = 0.f;
#pragma unroll
        for (int e = 0; e < 4; ++e) { o[e] = so[t * 256 + e * 64 + lane]; ss += o[e] * o[e]; }
        const float rstd = rsqrtf(wave_sum(ss) * (1.0f / 256.0f) + EPS);
        const float* nw = C.in[15] + layer * 256;
#pragma unroll
        for (int e = 0; e < 4; ++e) { const int vv = e * 64 + lane; const float z = bf2f(proj[(tokS + t) * ABNP + C_ZB + h * 256 + vv]);
            C.O[(tokS + t) * DM + 1024 + h * 256 + vv] = (bf16)f2bf(o[e] * rstd * nw[vv] * siluf_(z)); }
    }
    __syncthreads();
}

__device__ __forceinline__ void gatenorm_phase(const Ctx& C, int layer, int gwave, int ngw, int lane) {
    const bf16* OA = C.H;
    for (int m = gwave; m < NPT; m += ngw) {
#pragma unroll
        for (int st = 0; st < 4; ++st) {
            const int c0 = st * 512 + lane * 8;
            float o[8], z[8];
            unpack8(*(const v4u*)(OA + (size_t)m * DM + c0), o);
            const bool gdn = st < 2;
            const int zc = gdn ? (C_ZA + c0) : (C_ZB + (c0 - 1024));
            unpack8(*(const v4u*)(C.PROJ + (size_t)m * ABNP + zc), z);
            float ss = 0.f;
#pragma unroll
            for (int e = 0; e < 8; ++e) ss += o[e] * o[e];
            ss += __shfl_xor(ss, 1); ss += __shfl_xor(ss, 2); ss += __shfl_xor(ss, 4); ss += __shfl_xor(ss, 8);
            if (!gdn) ss += __shfl_xor(ss, 16);
            const float rstd = rsqrtf(ss * (gdn ? (1.0f / 128.0f) : (1.0f / 256.0f)) + EPS);
            const float* nw = gdn ? (C.in[12] + layer * 128 + (c0 & 127)) : (C.in[15] + layer * 256 + ((c0 - 1024) & 255));
            const f32x4 n0 = *(const f32x4*)nw, n1 = *(const f32x4*)(nw + 4);
            float r[8];
            r[0] = o[0] * rstd * n0.x * siluf_(z[0]); r[1] = o[1] * rstd * n0.y * siluf_(z[1]); r[2] = o[2] * rstd * n0.z * siluf_(z[2]); r[3] = o[3] * rstd * n0.w * siluf_(z[3]);
            r[4] = o[4] * rstd * n1.x * siluf_(z[4]); r[5] = o[5] * rstd * n1.y * siluf_(z[5]); r[6] = o[6] * rstd * n1.z * siluf_(z[6]); r[7] = o[7] * rstd * n1.w * siluf_(z[7]);
            *(v4u*)(C.O + (size_t)m * DM + c0) = pack8(r);
        }
    }
}

template <int PASS>
__device__ __forceinline__ void lru_item(const Ctx& C, int jl, int item, LAS unsigned char* lds) {
    const int tid = otid(), lane = tid & 63, w = tid >> 6, l15 = lane & 15, quad = lane >> 4;
    const bool sample = item >= 2048;
    const int it2 = sample ? item - 2048 : item;
    const int n = it2 & 15;
    const int chunk = sample ? 0 : (PASS == 3 ? (it2 >> 6) : ((it2 >> 4) & 31)), b = sample ? 0 : (PASS == 3 ? ((it2 >> 4) & 3) : (it2 >> 9)), bg = sample ? (it2 >> 4) : 0;
    const size_t tok0 = sample ? (size_t)NPT + bg * 64 : (size_t)b * TP + chunk * 64;
    LAS float* sXC = (LAS float*)lds;
    LAS float* sAa = sXC + 64 * 132;
    LAS float* sBb = sAa + 64 * 132;
    LAS float* sSegP = sBb + 64 * 132;
    LAS float* sSegH = sSegP + 1024;
    LAS float* sCarry = sSegH + 1024;
    LAS bf16* sXB = (LAS bf16*)(sCarry + 128);
    LAS float* sCP = (LAS float*)(sXB + 64 * 136);
    LAS float* sCH = sCP + 512;
    const bf16* proj = C.PROJ;
    const float* cw = C.in[19] + (size_t)jl * 4 * 2048;
    const int col = tid & 127, sg0 = tid >> 7;
    const int d = w * 16 + l15, chd = n * 128 + d;
    bf16x8 bA[4], bX[4];
#pragma unroll
    for (int kk = 0; kk < 4; ++kk) {
        bA[kk] = *(const bf16x8*)(C.WLA + (size_t)(jl * 16 + n) * 16384 + ((w * 4 + kk) * 64 + lane) * 8);
        bX[kk] = *(const bf16x8*)(C.WLX + (size_t)(jl * 16 + n) * 16384 + ((w * 4 + kk) * 64 + lane) * 8);
    }
    const float ba = C.in[22][jl * 2048 + chd], bx_ = C.in[24][jl * 2048 + chd], lam = C.in[25][jl * 2048 + chd];
    unsigned short gt[16]; float h0[2] = {0.f, 0.f};
    if (PASS >= 2) {
#pragma unroll
        for (int q = 0; q < 2; ++q) {
            const int sgm = sg0 + 4 * q;
#pragma unroll
            for (int r8 = 0; r8 < 8; ++r8) gt[q * 8 + r8] = proj[(tok0 + sgm * 8 + r8) * 4096 + 2048 + n * 128 + col];
            if (sample) h0[q] = C.in[5][(size_t)(jl * 128 + bg * 8 + sgm) * 2048 + n * 128 + col];
        }
    }
    float cP = 1.f, cH = 0.f;
    if (PASS == 2 && !sample) {
        float2 ph[8];
#pragma unroll
        for (int i = 0; i < 8; ++i) { const int cc = sg0 * 8 + i; ph[i] = (cc < chunk) ? *(const float2*)(C.SUM + ((size_t)(b * 32 + cc) * 2048 + n * 128 + col) * 2) : make_float2(1.f, 0.f); }
#pragma unroll
        for (int i = 0; i < 8; ++i) { cH = ph[i].x * cH + ph[i].y; cP *= ph[i].x; }
    }
    v4u xr[2][4];
#pragma unroll
    for (int u = 0; u < 2; ++u) {
        const int idx = tid + u * 512, r = idx >> 4, c8 = (idx & 15) * 8, chn = n * 128 + c8;
#pragma unroll
        for (int j = 0; j < 4; ++j) {
            xr[u][j] = (v4u){0u, 0u, 0u, 0u};
            if (!sample) { const int t = chunk * 64 + r - 3 + j; if (t >= 0) xr[u][j] = *(const v4u*)(proj + ((size_t)b * TP + t) * 4096 + chn); }
            else { const int bb = r >> 3, tl = (r & 7) - 3 + j;
                if (tl >= 0) xr[u][j] = *(const v4u*)(proj + ((size_t)NPT + (bg * 8 + bb) * 8 + tl) * 4096 + chn); }
        }
    }
#pragma unroll
    for (int u = 0; u < 2; ++u) {
        const int idx = tid + u * 512, r = idx >> 4, c8 = (idx & 15) * 8, chn = n * 128 + c8;
        float acc[8];
        { const f32x4 b0 = *(const f32x4*)(C.in[20] + jl * 2048 + chn), b1 = *(const f32x4*)(C.in[20] + jl * 2048 + chn + 4);
          acc[0] = b0.x; acc[1] = b0.y; acc[2] = b0.z; acc[3] = b0.w; acc[4] = b1.x; acc[5] = b1.y; acc[6] = b1.z; acc[7] = b1.w; }
#pragma unroll
        for (int j = 0; j < 4; ++j) {
            float x[8]; unpack8(xr[u][j], x);
            if (sample && j < 3) { const int tl = (r & 7) - 3 + j;
                if (tl < 0) { const float* sp = C.in[6] + ((size_t)(jl * 128 + bg * 8 + (r >> 3)) * 3 + (3 + tl)) * 2048 + chn; const f32x4 h0v = *(const f32x4*)sp, h1v = *(const f32x4*)(sp + 4);
                    x[0] = h0v.x; x[1] = h0v.y; x[2] = h0v.z; x[3] = h0v.w; x[4] = h1v.x; x[5] = h1v.y; x[6] = h1v.z; x[7] = h1v.w; } }
            const f32x4 w0 = *(const f32x4*)(cw + j * 2048 + chn), w1 = *(const f32x4*)(cw + j * 2048 + chn + 4);
            acc[0] += x[0] * w0.x; acc[1] += x[1] * w0.y; acc[2] += x[2] * w0.z; acc[3] += x[3] * w0.w;
            acc[4] += x[4] * w1.x; acc[5] += x[5] * w1.y; acc[6] += x[6] * w1.z; acc[7] += x[7] * w1.w;
            if (PASS >= 2 && j == 3) {
                float* o = nullptr;
                if (!sample) { if (chunk == 31 && r >= 61) o = C.out + O_PLCONV + ((size_t)(jl * 4 + b) * 3 + (r - 61)) * 2048 + chn; }
                else { if ((r & 7) >= 5) o = C.out + O_SLCONV + ((size_t)(jl * 128 + bg * 8 + (r >> 3)) * 3 + ((r & 7) - 5)) * 2048 + chn; }
                if (o) { *(f32x4*)o = (f32x4){x[0], x[1], x[2], x[3]}; *(f32x4*)(o + 4) = (f32x4){x[4], x[5], x[6], x[7]}; }
            }
        }
        *(LAS f32x4*)(sXC + r * 132 + c8) = (f32x4){acc[0], acc[1], acc[2], acc[3]};
        *(LAS f32x4*)(sXC + r * 132 + c8 + 4) = (f32x4){acc[4], acc[5], acc[6], acc[7]};
        *(LAS v4u*)(sXB + r * 136 + c8) = pack8(acc);
    }
    if (PASS == 2 && !sample) { sCP[sg0 * 128 + col] = cP; sCH[sg0 * 128 + col] = cH; }
    __syncthreads();
    if (PASS == 2 && !sample && tid < 128) {
        float hc = 0.f;
#pragma unroll
        for (int q = 0; q < 4; ++q) hc = sCP[q * 128 + tid] * hc + sCH[q * 128 + tid];
        sCarry[tid] = hc;
    }
    {
        f32x4 accA[4], accX[4];
#pragma unroll
        for (int m = 0; m < 4; ++m) { accA[m] = (f32x4){0.f, 0.f, 0.f, 0.f}; accX[m] = accA[m]; }
#pragma unroll
        for (int kk = 0; kk < 4; ++kk) {
#pragma unroll
            for (int m = 0; m < 4; ++m) {
                const bf16x8 a = *(const LAS bf16x8*)(sXB + (m * 16 + l15) * 136 + kk * 32 + quad * 8);
                accA[m] = __builtin_amdgcn_mfma_f32_16x16x32_bf16(a, bA[kk], accA[m], 0, 0, 0);
                accX[m] = __builtin_amdgcn_mfma_f32_16x16x32_bf16(a, bX[kk], accX[m], 0, 0, 0);
            }
        }
        const float c2 = -8.0f * 1.4426950408889634f * softplusf_(-lam);
#pragma unroll
        for (int m = 0; m < 4; ++m)
#pragma unroll
            for (int j = 0; j < 4; ++j) {
                const int row = m * 16 + quad * 4 + j;
                const float rg = sigmoidf_(accA[m][j] + ba), ig = sigmoidf_(accX[m][j] + bx_);
                const float a = __builtin_amdgcn_exp2f(c2 * rg);
                float mult = __builtin_amdgcn_sqrtf(fmaxf(1.0f - a * a, 0.f));
                if (!sample && chunk == 0 && row == 0) mult = 1.0f;
                sAa[row * 132 + d] = a; sBb[row * 132 + d] = mult * ig * sXC[row * 132 + d];
            }
    }
    __syncthreads();
#pragma unroll
    for (int q = 0; q < 2; ++q) {
        const int sgm = sg0 + 4 * q;
        float P = 1.f, hh = 0.f;
#pragma unroll
        for (int r8 = 0; r8 < 8; ++r8) { const int row = sgm * 8 + r8; const float a = sAa[row * 132 + col]; hh = a * hh + sBb[row * 132 + col]; P *= a; }
        sSegP[sgm * 128 + col] = P; sSegH[sgm * 128 + col] = hh;
    }
    __syncthreads();
    if (PASS == 3) {
        if (!sample && tid < 128) {
            float P = 1.f, hh = 0.f;
#pragma unroll
            for (int s = 0; s < 8; ++s) { const float ps = sSegP[s * 128 + tid]; hh = ps * hh + sSegH[s * 128 + tid]; P *= ps; }
            unsigned long long* gr = C.CARRY + ((size_t)((jl * 4 + b) * 32 + chunk) * 2048 + n * 128 + tid);
            float cin = 0.f;
            if (chunk > 0) {
                unsigned long long g = 0ull; unsigned spins = 0;
                for (;;) { g = __hip_atomic_load(gr - 2048, __ATOMIC_RELAXED, __HIP_MEMORY_SCOPE_AGENT); if ((unsigned)(g >> 32) == 1u || ++spins > (1u << 20)) break; __builtin_amdgcn_s_sleep(1); }
                cin = __uint_as_float((unsigned)g);
            }
            const float cout = P * cin + hh;
            __hip_atomic_store(gr, (1ull << 32) | (unsigned long long)__float_as_uint(cout), __ATOMIC_RELAXED, __HIP_MEMORY_SCOPE_AGENT);
            sCarry[tid] = cin;
        }
        __syncthreads();
    }
    if (PASS == 1) {
        if (tid < 128) {
            float P = 1.f, hh = 0.f;
#pragma unroll
            for (int s = 0; s < 8; ++s) { const float ps = sSegP[s * 128 + tid]; hh = ps * hh + sSegH[s * 128 + tid]; P *= ps; }
            *(float2*)(C.SUM + ((size_t)(b * 32 + chunk) * 2048 + n * 128 + tid) * 2) = make_float2(P, hh);
        }
    } else {
#pragma unroll
        for (int q = 0; q < 2; ++q) {
            const int sgm = sg0 + 4 * q;
            float hh;
            if (sample) hh = h0[q];
            else { hh = sCarry[col]; for (int s = 0; s < sgm; ++s) hh = sSegP[s * 128 + col] * hh + sSegH[s * 128 + col]; }
#pragma unroll
            for (int r8 = 0; r8 < 8; ++r8) {
                const int row = sgm * 8 + r8;
                hh = sAa[row * 132 + col] * hh + sBb[row * 132 + col];
                const float gate = bf2f(gt[q * 8 + r8]);
                C.O[(tok0 + row) * DM + n * 128 + col] = (bf16)f2bf(hh * siluf_(gate));
            }
            if (sample) C.out[O_SLRU + (size_t)(jl * 128 + bg * 8 + sgm) * 2048 + n * 128 + col] = hh;
            else if (chunk == 31 && sgm == 7) C.out[O_PLRU + (size_t)(jl * 4 + b) * 2048 + n * 128 + col] = hh;
        }
    }
    __syncthreads();
}

#define XB_TMO      128
#define XB_XCNT(j)  (256  + 64 * (j))
#define XB_XSUB(j)  (1280 + 64 * (j))
#define XB_XGEN(j)  (2304 + 64 * (j))
#define XB_TOP      3328
#define XB_TOPGEN   3392
#define XCD_BAR_WORDS 3456
#define XB_SPIN_CAP (1u << 18)

__device__ __forceinline__ unsigned xb_ld(unsigned* p)              { return __hip_atomic_load(p, __ATOMIC_RELAXED, __HIP_MEMORY_SCOPE_AGENT); }
__device__ __forceinline__ unsigned xb_add(unsigned* p, unsigned v) { return __hip_atomic_fetch_add(p, v, __ATOMIC_RELAXED, __HIP_MEMORY_SCOPE_AGENT); }
__device__ __forceinline__ unsigned xb_xcc_id() { return (unsigned)__builtin_amdgcn_s_getreg((3 << 11) | 20) & 0xFu; }
#define XB_SPIN(cond, bar) do { unsigned _sp = 0; while (cond) { __builtin_amdgcn_s_sleep(1); \
    if ((++_sp & 255u) == 0u) { if (xb_ld(&(bar)[XB_TMO])) break; if (_sp > XB_SPIN_CAP) { atomicAdd(&(bar)[XB_TMO], 1u); break; } } } } while (0)

struct XcdBarrier {
    unsigned* bar; unsigned x;
    volatile LAS unsigned* st;
};

__device__ __forceinline__ XcdBarrier xcd_barrier_post(unsigned* bar, volatile LAS unsigned* st) {
    XcdBarrier b; b.bar = bar; b.x = xb_xcc_id(); b.st = st;
    if (threadIdx.x == 0) (void)xb_add(&bar[XB_XCNT(b.x)], 1u);
    return b;
}
__device__ __forceinline__ void xcd_barrier_complete(unsigned* bar, unsigned x, unsigned& nloc, unsigned& nx) {
    const unsigned G = gridDim.x * gridDim.y * gridDim.z;
    unsigned sum, cnt, mine, sp = 0u;
    for (;;) {
        sum = 0u; cnt = 0u; mine = 0u;
#pragma unroll
        for (unsigned j = 0; j < 16; ++j) { const unsigned c = xb_ld(&bar[XB_XCNT(j)]); sum += c; cnt += (c > 0u) ? 1u : 0u; mine = (j == x) ? c : mine; }
        if (sum == G) break;
        __builtin_amdgcn_s_sleep(1);
        if ((++sp & 255u) == 0u) { if (xb_ld(&bar[XB_TMO])) break; if (sp > XB_SPIN_CAP) { atomicAdd(&bar[XB_TMO], 1u); break; } }
    }
    nloc = mine > 0u ? mine : 1u; nx = cnt > 0u ? cnt : 1u;
}

__device__ __forceinline__ void xcd_barrier(const XcdBarrier& b) {
    asm volatile("s_waitcnt vmcnt(0)" ::: "memory");
    __syncthreads();
    if (threadIdx.x == 0) {
        unsigned* bar = b.bar;
        __builtin_amdgcn_s_waitcnt(0);
        unsigned nloc = b.st[0], nx = b.st[1];
        if (nloc == 0u) { xcd_barrier_complete(bar, b.x, nloc, nx); b.st[0] = nloc; b.st[1] = nx; }
        const unsigned old = xb_add(&bar[XB_XSUB(b.x)], 1u);
        const unsigned gen = old / nloc;
        if (old + 1u == (gen + 1u) * nloc) {
            __builtin_amdgcn_fence(__ATOMIC_RELEASE, "agent");
            asm volatile("s_waitcnt vmcnt(0)" ::: "memory");
            const unsigned og = xb_add(&bar[XB_TOP], 1u);
            const unsigned tg = og / nx;
            if (og + 1u == (tg + 1u) * nx) xb_add(&bar[XB_TOPGEN], 1u);
            else XB_SPIN(xb_ld(&bar[XB_TOPGEN]) == tg, bar);
            __builtin_amdgcn_fence(__ATOMIC_ACQUIRE, "agent");
            xb_add(&bar[XB_XGEN(b.x)], 1u);
            asm volatile("s_waitcnt vmcnt(0)" ::: "memory");
        } else {
            XB_SPIN(xb_ld(&bar[XB_XGEN(b.x)]) == gen, bar);
            __builtin_amdgcn_fence(__ATOMIC_ACQUIRE, "agent");
            asm volatile("s_waitcnt vmcnt(0)" ::: "memory");
        }
    }
    __syncthreads();
}

struct OneUnit {
    int pm, pn;
    __device__ bool next(int i, pg8::Unit& u) const { if (i != 0) return false; u.pm = pm; u.pn = pn; return true; }
    __device__ __forceinline__ void a_ready(const pg8::Unit&) const {}
    __device__ __forceinline__ void done(const pg8::Unit&) const {}
};
constexpr int TAB_OFF = 143360;
__device__ __forceinline__ unsigned long long tab_ld(LAS unsigned char* lds, int i) {
    const volatile LAS unsigned* t = (const volatile LAS unsigned*)(lds + TAB_OFF) + 2 * i;
    const unsigned lo = __builtin_amdgcn_readfirstlane(t[0]), hi = __builtin_amdgcn_readfirstlane(t[1]);
    return ((unsigned long long)hi << 32) | lo;
}
__device__ __forceinline__ Ctx make_ctx(LAS unsigned char* lds) {
    Ctx C;
#pragma unroll
    for (int i = 0; i < 28; ++i) C.in[i] = (const float*)tab_ld(lds, i);
    C.out = (float*)tab_ld(lds, 28);
    unsigned char* ws = (unsigned char*)tab_ld(lds, 29);
    C.G = gridDim.x;
    C.WABIN = (bf16*)(ws + WS_WABIN); C.WABOUT = (bf16*)(ws + WS_WABOUT); C.WLIN = (bf16*)(ws + WS_WLIN); C.WLOUT = (bf16*)(ws + WS_WLOUT);
    C.WLA = (bf16*)(ws + WS_WLA); C.WLX = (bf16*)(ws + WS_WLX);
    C.X = (float*)(ws + WS_X); C.H = (bf16*)(ws + WS_H); C.O = (bf16*)(ws + WS_O); C.PROJ = (bf16*)(ws + WS_PROJ);
    C.G_W = (bf16*)(ws + WS_GW); C.G_QG = (bf16*)(ws + WS_GQG); C.G_KDT = (bf16*)(ws + WS_GKDT); C.G_QK = (bf16*)(ws + WS_GQK); C.G_UT = (float*)(ws + WS_GUT);
    C.L_QG = (bf16*)(ws + WS_LQG); C.L_KDT = (bf16*)(ws + WS_LKDT); C.L_A = (bf16*)(ws + WS_LA); C.L_VT = (bf16*)(ws + WS_LVT);
    C.G_DEC = (float*)(ws + WS_GDEC); C.L_DEC = (float*)(ws + WS_LDEC); C.SUM = (float*)(ws + WS_SUM); C.SS = (float*)(ws + 65536); C.CARRY = (unsigned long long*)(ws + WS_CARRY);
    return C;
}
#ifndef TYPE_MASK
#define TYPE_MASK 0xFFFF
#endif
#define TY(t) ((TYPE_MASK >> (t)) & 1)
#ifndef REP_MASK
#define REP_MASK 0
#endif
#define REP(t) for (int rep_ = 0; rep_ < (((REP_MASK >> (t)) & 1) ? 2 : 1); ++rep_)
__global__ void __launch_bounds__(512, 2) mk_fwd(Params p) {
    extern __shared__ __attribute__((aligned(16))) unsigned char lds_raw[];
    LAS unsigned char* lds = (LAS unsigned char*)lds_raw;
    if (threadIdx.x == 0) {
        LAS unsigned long long* t = (LAS unsigned long long*)(lds + TAB_OFF);
#pragma unroll
        for (int i = 0; i < 28; ++i) t[i] = (unsigned long long)p.in[i];
        t[28] = (unsigned long long)p.out; t[29] = (unsigned long long)p.ws;
    }
    if (threadIdx.x < 2) ((LAS unsigned*)(lds + TAB_OFF + 256))[threadIdx.x] = 0u;
    __syncthreads();
    const int lo = p.ph_lo, hi = p.ph_hi;
    const int G = gridDim.x;
    cg::grid_group grid = cg::this_grid();
    XcdBarrier xbar; xbar.bar = (unsigned*)p.ws; xbar.x = 0; xbar.st = nullptr;
    if (hi - lo > 1) xbar = xcd_barrier_post((unsigned*)p.ws, (volatile LAS unsigned*)(lds + TAB_OFF + 256));
#define IN(k) (lo <= (k) && (k) < hi)
#define SEAM2(k, kn) do { if (IN(k) && IN(kn)) { xcd_barrier(xbar); } } while (0)
    if (hi < 0) grid.sync();
#define SEAM(k) do { if (IN(k) && IN((k) + 1)) { xcd_barrier(xbar); } } while (0)
#define GW_DECL const int tid_ = otid(), bid = obid(), lane = tid_ & 63, gw = bid * 8 + (tid_ >> 6), NGW = G * 8

    REP(0) if (TY(0) && IN(0)) { const Ctx C = make_ctx(lds); prologue_phase(C, lds); }
    SEAM(0);
#pragma unroll 1
    for (int l = 0; l < 4; ++l) {
        const int j = l >> 1;
        if ((l & 1) == 0) {
            const int P0 = (l == 0) ? 1 : 12;
            REP(1) if (TY(1) && IN(P0)) {
                const Ctx C = make_ctx(lds); const int bid = obid();
                pg8::Gemm g{C.H, C.WABIN + (size_t)j * ABNP * 2048, NTOK, ABNP, DM}; pg8::StaticOrder S; S.init(NTOK, ABNP, G, bid);
                pg8::EpiProj E{C.PROJ, ABNP, (l == 0) ? (const float*)nullptr : C.SS + (size_t)(l - 1) * NTOK};
                pg8::gemm_phase<pg8::EpiProj, pg8::StaticOrder, true, true>(lds, g, S, E);
                if (l == 0 && G == 256) convert_segment(C, lds, 1, 20);
            }
            SEAM(P0);
            REP(2) if (TY(2) && IN(P0 + 1)) {
                const Ctx C = make_ctx(lds); const int bid = obid();
                for (int it = bid; it < 1536; it += G) { if (it < 1024) gdn_prep_item(C, j, it, lds); else gla_prep_item(C, j, it - 1024, lds); }
            }
            SEAM(P0 + 1);
            REP(3) if (TY(3) && IN(P0 + 2)) {
                const Ctx C = make_ctx(lds); const int bid = obid();
                REP(13) if (G == 256) {
                    const int xcd = bid & 7, slot = bid >> 3;
                    if (slot < 16) scan_task<true>(C, j, (xcd * 4 + (slot >> 2)) * 4 + (slot & 3), lds);
                    else scan_task<false>(C, j, (xcd * 2 + ((slot - 16) >> 3)) * 8 + ((slot - 16) & 7), lds);
                } else
                for (int t = bid; t < 256; t += G) { if (t < 128) scan_task<true>(C, j, t, lds); else scan_task<false>(C, j, t - 128, lds); }
                for (int it = bid; it < 1536; it += G) { if (it < 1024) gdn_sample_item(C, j, it, lds); else gla_sample_item(C, j, it - 1024, lds); }
            }
            SEAM(P0 + 2);
            REP(4) if (TY(4) && IN(P0 + 3)) {
                const Ctx C = make_ctx(lds);
                if (G == 256) {
                    const int bid = obid();
                    if (bid < 32) {
                        const float* resS = (l == 0) ? C.in[1] : C.X + (size_t)NPT * DM;
                        pg8::Gemm g{C.O, C.WABOUT + (size_t)j * 2048 * 2048, NTOK, DM, DM}; OneUnit S1{32 + (bid >> 3), bid & 7};
                        pg8::EpiRes E{C.X, resS, C.X, DM, C.H, C.in[17] + j * DM, C.SS + (size_t)l * NTOK};
                        pg8::gemm_phase<pg8::EpiRes, OneUnit, true, true>(lds, g, S1, E);
                    } else {
                        const int tid_ = otid(), lane = tid_ & 63;
                        gatenorm_phase(C, j, (bid - 32) * 8 + (tid_ >> 6), 224 * 8, lane);
                        if (l == 0) convert_segment(C, lds, 2, 32);
                    }
                } else { GW_DECL; gatenorm_phase(C, j, gw, NGW, lane); }
            }
            SEAM(P0 + 3);
            REP(5) if (TY(5) && IN(P0 + 4)) {
                const Ctx C = make_ctx(lds); const int bid = obid();
                const float* resP = (l == 0) ? C.in[0] : C.X;
                const float* resS = (l == 0) ? C.in[1] : C.X + (size_t)NPT * DM;
                pg8::Gemm g{C.O, C.WABOUT + (size_t)j * 2048 * 2048, NTOK, DM, DM}; pg8::StaticOrder S; S.init((G == 256) ? NPT : NTOK, DM, G, bid);
                pg8::EpiRes E{resP, resS, C.X, DM, C.H, C.in[17] + j * DM, C.SS + (size_t)l * NTOK};
                pg8::gemm_phase<pg8::EpiRes, pg8::StaticOrder, true, true>(lds, g, S, E);
            }
            SEAM2(P0 + 4, P0 + 6);
        } else {
            const int P0 = (l == 1) ? 7 : 18;
            REP(7) if (TY(7) && IN(P0)) {
                const Ctx C = make_ctx(lds); const int bid = obid();
                pg8::Gemm g{C.H, C.WLIN + (size_t)j * 4096 * 2048, NTOK, 4096, DM}; pg8::StaticOrder S; S.init(NTOK, 4096, G, bid);
                pg8::EpiProj E{C.PROJ, 4096, C.SS + (size_t)(l - 1) * NTOK};
                pg8::gemm_phase<pg8::EpiProj, pg8::StaticOrder, true, true>(lds, g, S, E);
                if (l == 1 && G == 256) convert_segment(C, lds, 3, 64);
            }
            SEAM2(P0, P0 + 2);
            REP(9) if (TY(9) && IN(P0 + 2)) { const Ctx C = make_ctx(lds); const int bid = obid(); for (int it = bid; it < 2304; it += G) lru_item<3>(C, j, it, lds); }
            SEAM(P0 + 2);
            REP(10) if (TY(10) && IN(P0 + 3)) {
                const Ctx C = make_ctx(lds); const int bid = obid();
                pg8::Gemm g{C.O, C.WLOUT + (size_t)j * 2048 * 2048, NTOK, DM, DM}; pg8::StaticOrder S; S.init(NTOK, DM, G, bid);
                pg8::EpiRes E{C.X, C.X + (size_t)NPT * DM, C.X, DM, (l == 1) ? C.H : (bf16*)nullptr, C.in[7] + DM, C.SS + (size_t)l * NTOK};
                pg8::gemm_phase<pg8::EpiRes, pg8::StaticOrder, true, true>(lds, g, S, E);
                if (l == 1 && G == 256) convert_segment(C, lds, 4, 32);
            }
            if (l == 1) SEAM2(P0 + 3, P0 + 5); else SEAM(P0 + 3);
            REP(11) if (TY(11) && IN(P0 + 4)) {
                const Ctx C = make_ctx(lds); GW_DECL;
                if (l == 3) rms_phase_f32(C.X, C.in[27], C.out, gw, NGW, lane);
            }
        }
    }
#undef IN
#undef SEAM
}

extern "C" void kernel_launch(void* const* d_in, const int* in_sizes, int n_in, void* d_out, int out_size, void* d_ws, size_t ws_size, hipStream_t stream) {
    static int grid = 0;
    if (grid == 0) {
        if (n_in != 28 || ws_size < WS_END || (size_t)out_size != O_END) { fprintf(stderr, "kernel_launch: unexpected problem (n_in %d, out %d, ws %zu)\n", n_in, out_size, ws_size); grid = -1; return; }
        int dev = 0, cus = 0, per_cu = 0;
        if (hipGetDevice(&dev) != hipSuccess || hipDeviceGetAttribute(&cus, hipDeviceAttributeMultiprocessorCount, dev) != hipSuccess) { grid = -1; return; }
        if (hipFuncSetAttribute((const void*)mk_fwd, hipFuncAttributeMaxDynamicSharedMemorySize, LDS_BYTES) != hipSuccess) { fprintf(stderr, "kernel_launch: hipFuncSetAttribute failed\n"); grid = -1; return; }
        if (hipOccupancyMaxActiveBlocksPerMultiprocessor(&per_cu, (const void*)mk_fwd, 512, LDS_BYTES) != hipSuccess || per_cu < 1) { fprintf(stderr, "kernel_launch: occupancy query says %d\n", per_cu); per_cu = 1; }
        (void)hipGetLastError();
        grid = cus * per_cu;
    }
    if (grid < 0) return;
    if (hipMemsetAsync(d_ws, 0, 262144, stream) != hipSuccess) { fprintf(stderr, "kernel_launch: memset failed\n"); return; }
    if (hipMemsetAsync((char*)d_ws + WS_CARRY, 0, 4 * MiB, stream) != hipSuccess) { fprintf(stderr, "kernel_launch: memset failed\n"); return; }
    Params p{};
    for (int i = 0; i < 28; ++i) p.in[i] = (const float*)d_in[i];
    p.out = (float*)d_out; p.ws = (unsigned char*)d_ws;
#if ONE_LAUNCH
    p.ph_lo = 0; p.ph_hi = NPHASE;
    void* args[] = {&p};
    hipError_t e = hipLaunchCooperativeKernel((const void*)mk_fwd, dim3(grid), dim3(512), args, LDS_BYTES, stream);
    if (e != hipSuccess) fprintf(stderr, "cooperative launch failed: %s (grid %d)\n", hipGetErrorString(e), grid);
#else
    for (int k = 0; k < NPHASE; ++k) {
        p.ph_lo = k; p.ph_hi = k + 1;
        hipLaunchKernelGGL(mk_fwd, dim3(grid), dim3(512), LDS_BYTES, stream, p);
    }
#endif
}
```

```cpp
#include <hip/hip_runtime.h>
#include <hip/hip_cooperative_groups.h>
#include <cstdio>
#include <cstdint>
namespace cg = cooperative_groups;
namespace pg8 {
#define PG8_LAS __attribute__((address_space(3)))
typedef unsigned short bf16_t;
typedef short bf16x8 __attribute__((ext_vector_type(8)));
typedef float f32x4 __attribute__((ext_vector_type(4)));
typedef unsigned u32x4 __attribute__((ext_vector_type(4)));
constexpr int BM = 256, BK = 64, HALF = 128, HTB = HALF * BK * 2  , STAGE_BYTES = 8 * HTB, NXCD = 8, WGM = 8;

__host__ __device__ __forceinline__ int lds_byte(int r, int c) { const int st = (r >> 4) * 2 + (c >> 5), rr = r & 15, cc = c & 31, ob = rr * 64 + cc * 2; return st * 1024 + (ob ^ (((ob >> 9) & 1) << 5)); }
__host__ __device__ __forceinline__ void stage_rc(int b, int& R, int& C) { const int st = b / 1024, sb = b % 1024, swz = sb ^ (((sb >> 9) & 1) << 5); R = (st >> 1) * 16 + swz / 64; C = (st & 1) * 32 + (swz % 64) / 2; }
__host__ __device__ __forceinline__ int perm32(int rho) { const int n = rho >> 4, i = rho & 15; return 8 * (i >> 2) + 4 * n + (i & 3); }

struct Unit { int pm, pn; };
struct Gemm { const bf16_t* A; const bf16_t* Bt; int M, N, K; };

struct StaticOrder {
    int nM, nN, nwg, G, c;
    __host__ __device__ void init(int M, int N, int G_, int c_) { nM = M / BM; nN = N / BM; nwg = nM * nN; G = G_; c = c_; }
    __host__ __device__ bool next(int i, Unit& u) const {
        const long L = (long)i * G + c; if (L >= nwg) return false;
        int wgid = (int)L; { const int q = nwg / NXCD, r = nwg % NXCD, xcd = wgid % NXCD, off = wgid / NXCD; wgid = (xcd < r ? xcd * (q + 1) : r * (q + 1) + (xcd - r) * q) + off; }
        const int nig = WGM * nN, gid = wgid / nig, fm = gid * WGM, gsz = (nM - fm) < WGM ? (nM - fm) : WGM;
        u.pm = fm + ((wgid % nig) % gsz); u.pn = (wgid % nig) / gsz; return true;
    }
    __device__ __forceinline__ void a_ready(const Unit&) const {}
    __device__ __forceinline__ void done(const Unit&) const {}
};

__device__ __forceinline__ unsigned cvt_pk_bf16(float lo, float hi) { unsigned r; asm volatile("v_cvt_pk_bf16_f32 %0, %1, %2" : "=v"(r) : "v"(lo), "v"(hi)); return r; }
typedef float f32x2 __attribute__((ext_vector_type(2)));
struct EpiProj {
    static constexpr bool PERM = true, AFTER_DRAIN = false;
    bf16_t* O; int ldc; const float* ss;
    __device__ __forceinline__ void operator()(const f32x4 (&acc)[2][2][4][2], const Unit& u, int wr, int wc, int fr, int fq) const {
        const int row0 = u.pm * BM + wr * 64 + fr, col0 = u.pn * BM + wc * 32 + 8 * fq;
#pragma unroll
        for (int ai = 0; ai < 2; ++ai)
#pragma unroll
            for (int m = 0; m < 4; ++m) { bf16_t* rowp = O + (size_t)(row0 + ai * HALF + m * 16) * ldc + col0;
                const float rs = ss ? rsqrtf(ss[row0 + ai * HALF + m * 16] * (1.0f / 2048.0f) + 1e-6f) : 1.0f;
#pragma unroll
                for (int bj = 0; bj < 2; ++bj) { const f32x4 v0 = acc[ai][bj][m][0] * rs, v1 = acc[ai][bj][m][1] * rs;
                    u32x4 w; w.x = cvt_pk_bf16(v0[0], v0[1]); w.y = cvt_pk_bf16(v0[2], v0[3]); w.z = cvt_pk_bf16(v1[0], v1[1]); w.w = cvt_pk_bf16(v1[2], v1[3]);
                    *(u32x4*)(rowp + bj * HALF) = w; } }
    }
};
struct EpiRes {
    static constexpr bool PERM = false, AFTER_DRAIN = false;
    const float* baseP; const float* baseS; float* out; int ldc;
    bf16_t* Hn; const float* gn; float* ss;
    __device__ __forceinline__ void operator()(const f32x4 (&acc)[2][2][4][2], const Unit& u, int wr, int wc, int fr, int fq) const {
        const int row0 = u.pm * BM + wr * 64 + fr, col0 = u.pn * BM + wc * 32 + 4 * fq;
        f32x4 g4[2][2];
        if (Hn) {
#pragma unroll
            for (int bj = 0; bj < 2; ++bj)
#pragma unroll
                for (int n = 0; n < 2; ++n) g4[bj][n] = *(const f32x4*)(gn + col0 + bj * HALF + n * 16);
        }
#pragma unroll
        for (int ai = 0; ai < 2; ++ai)
#pragma unroll
            for (int m = 0; m < 4; ++m) { const int row = row0 + ai * HALF + m * 16;
                const float* bp = (row < 8192 ? baseP + (size_t)row * ldc : baseS + (size_t)(row - 8192) * ldc) + col0;
                float* op = out + (size_t)row * ldc + col0;
                float part = 0.f;
#pragma unroll
                for (int bj = 0; bj < 2; ++bj)
#pragma unroll
                    for (int n = 0; n < 2; ++n) { const f32x4 v = *(const f32x4*)(bp + bj * HALF + n * 16) + acc[ai][bj][m][n];
                        *(f32x4*)(op + bj * HALF + n * 16) = v;
                        if (Hn) { part += (v[0] * v[0] + v[1] * v[1]) + (v[2] * v[2] + v[3] * v[3]); const f32x4 gg = g4[bj][n];
                            unsigned w0 = cvt_pk_bf16(v[0] * gg[0], v[1] * gg[1]), w1 = cvt_pk_bf16(v[2] * gg[2], v[3] * gg[3]);
                            typedef unsigned u32x2 __attribute__((ext_vector_type(2)));
                            *(u32x2*)(Hn + (size_t)row * ldc + col0 + bj * HALF + n * 16) = (u32x2){w0, w1}; } }
                if (Hn) { part += __shfl_xor(part, 16); part += __shfl_xor(part, 32); if (fq == 0) unsafeAtomicAdd(ss + row, part); } }
    }
};
template <class Epi, class Sched, bool ALIGN_EPI = false, bool SP2 = false>
__device__ __forceinline__ void gemm_phase(PG8_LAS unsigned char* lds, const Gemm g, const Sched& S, const Epi& E) {
    int tid = threadIdx.x; asm volatile("" : "+v"(tid)); const int wid = __builtin_amdgcn_readfirstlane(tid >> 6), lane = tid & 63, wr = wid >> 2, wc = wid & 3, fr = lane & 15, fq = lane >> 4;
    const int K = g.K, nt = K / BK;
    unsigned voffA[2], voffB[2];
#pragma unroll
    for (int i = 0; i < 2; ++i) { int R, C; stage_rc(tid * 16 + i * 8192, R, C); const int Rb = Epi::PERM ? ((R & ~31) + perm32(R & 31)) : R;
        voffA[i] = (unsigned)(R * K + C) * 2u; voffB[i] = (unsigned)(Rb * K + C) * 2u; }
    const size_t kstep = (size_t)(BK * 2);
    const size_t hstep = (size_t)HALF * K * 2;
    const size_t tstep = 2 * hstep;
    const unsigned ldsw = (unsigned)wid * 1024u;
    const int aoff = lds_byte(wr * 64 + fr, fq * 8), boff = lds_byte(wc * 32 + fr, fq * 8);
#define PG8_SA(b, h) (((b) * 2 + (h)) * HTB)
#define PG8_SB(b, h) ((4 + (b) * 2 + (h)) * HTB)
#define PG8_STAGE(bufoff, gbase, voff) do { _Pragma("unroll") for (int _i = 0; _i < 2; ++_i) \
        __builtin_amdgcn_global_load_lds((const unsigned*)((const char*)(gbase) + (voff)[_i]), (PG8_LAS unsigned*)(lds + (bufoff) + ldsw + _i * 8192), 16, 0, 0); } while (0)
#define PG8_LDA(dst, b, h) do { _Pragma("unroll") for (int m = 0; m < 4; ++m) _Pragma("unroll") for (int k = 0; k < 2; ++k) dst[m][k] = *(const PG8_LAS bf16x8*)(lds + PG8_SA(b, h) + aoff + m * 2048 + k * 1024); } while (0)
#define PG8_LDB(dst, b, h) do { _Pragma("unroll") for (int n = 0; n < 2; ++n) _Pragma("unroll") for (int k = 0; k < 2; ++k) dst[n][k] = *(const PG8_LAS bf16x8*)(lds + PG8_SB(b, h) + boff + n * 2048 + k * 1024); } while (0)
#define PG8_MMA(ai, bj, At, Bt) do { __builtin_amdgcn_s_setprio(1); _Pragma("unroll") for (int m = 0; m < 4; ++m) _Pragma("unroll") for (int n = 0; n < 2; ++n) _Pragma("unroll") for (int k = 0; k < 2; ++k) \
        acc[ai][bj][m][n] = __builtin_amdgcn_mfma_f32_16x16x32_bf16(Bt[n][k], At[m][k], acc[ai][bj][m][n], 0, 0, 0); __builtin_amdgcn_s_setprio(0); } while (0)
#define PG8_WAIT_V(n) asm volatile("s_waitcnt vmcnt(" #n ")" ::: "memory")
#define PG8_WAIT_L(n) asm volatile("s_waitcnt lgkmcnt(" #n ")" ::: "memory")
#define PG8_BAR __builtin_amdgcn_s_barrier()
#define PG8_SCHED __builtin_amdgcn_sched_barrier(0)
    Unit cur, nxt; int ui = 0;
    if (!S.next(0, cur)) return;
    f32x4 acc[2][2][4][2];
#pragma unroll
    for (int a = 0; a < 2; ++a)
#pragma unroll
        for (int b = 0; b < 2; ++b)
#pragma unroll
            for (int m = 0; m < 4; ++m)
#pragma unroll
                for (int n = 0; n < 2; ++n) acc[a][b][m][n] = (f32x4){0.f, 0.f, 0.f, 0.f};
    bf16x8 At[4][2], B0[2][2], B1[2][2];
    const char* cA = (const char*)g.A + (size_t)cur.pm * tstep; const char* cB = (const char*)g.Bt + (size_t)cur.pn * tstep;
    S.a_ready(cur);
    if constexpr (SP2) {
        PG8_STAGE(PG8_SB(0, 0), cB, voffB); PG8_STAGE(PG8_SB(0, 1), cB + hstep, voffB); PG8_STAGE(PG8_SA(0, 0), cA, voffA); PG8_STAGE(PG8_SA(0, 1), cA + hstep, voffA);
        if (wr == 1) PG8_BAR;
        PG8_WAIT_V(2); PG8_BAR;
        PG8_STAGE(PG8_SB(1, 0), cB + kstep, voffB); PG8_STAGE(PG8_SA(1, 0), cA + kstep, voffA); PG8_STAGE(PG8_SB(1, 1), cB + hstep + kstep, voffB);
        PG8_WAIT_V(6); PG8_BAR;
    } else {
        PG8_STAGE(PG8_SB(0, 0), cB, voffB); PG8_STAGE(PG8_SA(0, 0), cA, voffA); PG8_STAGE(PG8_SB(0, 1), cB + hstep, voffB); PG8_STAGE(PG8_SA(0, 1), cA + hstep, voffA);
        if (wr == 1) PG8_BAR;
        PG8_WAIT_V(4); PG8_BAR;
        PG8_STAGE(PG8_SB(1, 0), cB + kstep, voffB); PG8_STAGE(PG8_SA(1, 0), cA + kstep, voffA); PG8_STAGE(PG8_SB(1, 1), cB + hstep + kstep, voffB);
        PG8_WAIT_V(6); PG8_BAR;
    }
    for (;;) {
        const bool has_next = S.next(ui + 1, nxt);
        const char* nA = has_next ? (const char*)g.A + (size_t)nxt.pm * tstep : cA; const char* nB = has_next ? (const char*)g.Bt + (size_t)nxt.pn * tstep : cB;
        for (int t = 0; t < nt; t += 2) {
            const bool last = (t == nt - 2);
            const char* a1 = cA + (size_t)(t + 1) * kstep;
            const char* a2 = last ? nA : cA + (size_t)(t + 2) * kstep; const char* b2 = last ? nB : cB + (size_t)(t + 2) * kstep;
            const char* a3 = a2 + kstep; const char* b3 = b2 + kstep;
            if (last && has_next) S.a_ready(nxt);
            if constexpr (SP2) {
            PG8_LDB(B0, 0, 0); PG8_LDB(B1, 0, 1); PG8_SCHED; PG8_LDA(At, 0, 0); PG8_STAGE(PG8_SA(1, 1), a1 + hstep, voffA);
            PG8_WAIT_V(8); PG8_WAIT_L(0); PG8_BAR; PG8_MMA(0, 0, At, B0); PG8_MMA(0, 1, At, B1); PG8_BAR; PG8_SCHED;
            PG8_LDA(At, 0, 1); PG8_STAGE(PG8_SB(0, 0), b2, voffB); PG8_STAGE(PG8_SB(0, 1), b2 + hstep, voffB); PG8_STAGE(PG8_SA(0, 0), a2, voffA);
            PG8_WAIT_V(8); PG8_WAIT_L(0); PG8_BAR; PG8_MMA(1, 0, At, B0); PG8_MMA(1, 1, At, B1); PG8_BAR; PG8_SCHED;
            PG8_LDB(B0, 1, 0); PG8_LDB(B1, 1, 1); PG8_SCHED; PG8_LDA(At, 1, 0); PG8_STAGE(PG8_SA(0, 1), a2 + hstep, voffA);
            PG8_WAIT_V(8); PG8_WAIT_L(0); PG8_BAR; PG8_MMA(0, 0, At, B0); PG8_MMA(0, 1, At, B1); PG8_BAR; PG8_SCHED;
            PG8_LDA(At, 1, 1); PG8_STAGE(PG8_SB(1, 0), b3, voffB); PG8_STAGE(PG8_SB(1, 1), b3 + hstep, voffB); PG8_STAGE(PG8_SA(1, 0), a3, voffA);
            PG8_WAIT_V(8); PG8_WAIT_L(0); PG8_BAR; PG8_MMA(1, 0, At, B0); PG8_MMA(1, 1, At, B1); PG8_BAR; PG8_SCHED;
            } else {
            PG8_LDB(B0, 0, 0); PG8_SCHED; PG8_LDA(At, 0, 0); PG8_STAGE(PG8_SA(1, 1), a1 + hstep, voffA);
            PG8_WAIT_L(8); PG8_BAR; PG8_WAIT_L(0); PG8_MMA(0, 0, At, B0); PG8_BAR; PG8_SCHED;
            PG8_LDB(B1, 0, 1); PG8_STAGE(PG8_SB(0, 0), b2, voffB);
            PG8_BAR; PG8_WAIT_L(0); PG8_MMA(0, 1, At, B1); PG8_BAR;
            PG8_LDA(At, 0, 1); PG8_STAGE(PG8_SA(0, 0), a2, voffA);
            PG8_BAR; PG8_WAIT_L(0); PG8_MMA(1, 0, At, B0); PG8_BAR; PG8_SCHED;
            PG8_STAGE(PG8_SB(0, 1), b2 + hstep, voffB);
            PG8_WAIT_V(6); PG8_BAR; PG8_MMA(1, 1, At, B1); PG8_BAR;
            PG8_LDB(B0, 1, 0); PG8_SCHED; PG8_LDA(At, 1, 0); PG8_STAGE(PG8_SA(0, 1), a2 + hstep, voffA);
            PG8_WAIT_L(8); PG8_BAR; PG8_WAIT_L(0); PG8_MMA(0, 0, At, B0); PG8_BAR; PG8_SCHED;
            PG8_LDB(B1, 1, 1); PG8_STAGE(PG8_SB(1, 0), b3, voffB);
            PG8_BAR; PG8_WAIT_L(0); PG8_MMA(0, 1, At, B1); PG8_BAR;
            PG8_LDA(At, 1, 1); PG8_STAGE(PG8_SA(1, 0), a3, voffA);
            PG8_BAR; PG8_WAIT_L(0); PG8_MMA(1, 0, At, B0); PG8_BAR; PG8_SCHED;
            PG8_STAGE(PG8_SB(1, 1), b3 + hstep, voffB);
            PG8_WAIT_V(6); PG8_BAR; PG8_MMA(1, 1, At, B1); PG8_BAR;
            }
        }
        if constexpr (ALIGN_EPI) { if (wr == 0) PG8_BAR; }
        if constexpr (!Epi::AFTER_DRAIN) { E(acc, cur, wr, wc, fr, fq); S.done(cur); }
        if (!has_next) break;
#pragma unroll
        for (int a = 0; a < 2; ++a)
#pragma unroll
            for (int b = 0; b < 2; ++b)
#pragma unroll
                for (int m = 0; m < 4; ++m)
#pragma unroll
                    for (int n = 0; n < 2; ++n) acc[a][b][m][n] = (f32x4){0.f, 0.f, 0.f, 0.f};
        cur = nxt; cA = nA; cB = nB; ++ui;
        if constexpr (ALIGN_EPI) { if (wr == 1) PG8_BAR; }
    }
    PG8_WAIT_V(0);
    if constexpr (!ALIGN_EPI) { if (wr == 0) PG8_BAR; }
    PG8_BAR;
    if constexpr (Epi::AFTER_DRAIN) { E.fused(acc, cur, wr, wc, fr, fq, lds, wid, lane); S.done(cur); }
#undef PG8_SA
#undef PG8_SB
#undef PG8_STAGE
#undef PG8_LDA
#undef PG8_LDB
#undef PG8_MMA
#undef PG8_WAIT_V
#undef PG8_WAIT_L
#undef PG8_BAR
#undef PG8_SCHED
}
}

#define LAS __attribute__((address_space(3)))
typedef unsigned short bf16;
typedef unsigned v4u __attribute__((ext_vector_type(4)));
typedef unsigned v2u __attribute__((ext_vector_type(2)));
typedef float f32x4 __attribute__((ext_vector_type(4)));
typedef short bf16x8 __attribute__((ext_vector_type(8)));

#ifndef ONE_LAUNCH
#define ONE_LAUNCH 1
#endif

constexpr int DM = 2048, NTOK = 9216, NPT = 8192, TP = 2048;
constexpr int ABNP = 7424;
constexpr int C_BRAW = 3072, C_ARAW = 3080, C_ZA = 3088, C_QB = 4112, C_KB = 4624, C_VB = 5136, C_LR = 6160, C_ZB = 6176;
constexpr float EPS = 1e-6f;
constexpr int NPHASE = 23;
constexpr int LDS_BYTES = 147456;

constexpr size_t O_YP = 0;
constexpr size_t O_YS = O_YP + (size_t)4 * 2048 * 2048;
constexpr size_t O_PDELTA = O_YS + (size_t)128 * 8 * 2048;
constexpr size_t O_PDCONV = O_PDELTA + (size_t)2 * 4 * 8 * 128 * 128;
constexpr size_t O_PGLA = O_PDCONV + (size_t)2 * 4 * 3 * 3072;
constexpr size_t O_PLRU = O_PGLA + (size_t)2 * 4 * 4 * 128 * 256;
constexpr size_t O_PLCONV = O_PLRU + (size_t)2 * 4 * 2048;
constexpr size_t O_SDELTA = O_PLCONV + (size_t)2 * 4 * 3 * 2048;
constexpr size_t O_SDCONV = O_SDELTA + (size_t)2 * 128 * 8 * 128 * 128;
constexpr size_t O_SGLA = O_SDCONV + (size_t)2 * 128 * 3 * 3072;
constexpr size_t O_SLRU = O_SGLA + (size_t)2 * 128 * 4 * 128 * 256;
constexpr size_t O_SLCONV = O_SLRU + (size_t)2 * 128 * 2048;
constexpr size_t O_END = O_SLCONV + (size_t)2 * 128 * 3 * 2048;
static_assert(O_END == 92676096, "output size");

constexpr size_t MiB = 1u << 20;
constexpr size_t WS_WABIN = 1 * MiB;
constexpr size_t WS_WABOUT = WS_WABIN + 58 * MiB;
constexpr size_t WS_WLIN = WS_WABOUT + 16 * MiB;
constexpr size_t WS_WLOUT = WS_WLIN + 32 * MiB;
constexpr size_t WS_WLA = WS_WLOUT + 16 * MiB;
constexpr size_t WS_WLX = WS_WLA + 1 * MiB;
constexpr size_t WS_X = WS_WLX + 1 * MiB;
constexpr size_t WS_H = WS_X + 72 * MiB;
constexpr size_t WS_O = WS_H + 36 * MiB;
constexpr size_t WS_PROJ = WS_O + 36 * MiB;
constexpr size_t WS_GW = WS_PROJ + 131 * MiB;
constexpr size_t WS_GQG = WS_GW + 16 * MiB;
constexpr size_t WS_GKDT = WS_GQG + 16 * MiB;
constexpr size_t WS_GQK = WS_GKDT + 16 * MiB;
constexpr size_t WS_GUT = WS_GQK + 8 * MiB;
constexpr size_t WS_LQG = WS_GUT + 32 * MiB;
constexpr size_t WS_LKDT = WS_LQG + 8 * MiB;
constexpr size_t WS_LA = WS_LKDT + 8 * MiB;
constexpr size_t WS_LVT = WS_LA + 4 * MiB;
constexpr size_t WS_GDEC = WS_LVT + 16 * MiB;
constexpr size_t WS_LDEC = WS_GDEC + 1 * MiB;
constexpr size_t WS_SUM = WS_LDEC + 1 * MiB;
constexpr size_t WS_CARRY = WS_SUM + 2 * MiB;
constexpr size_t WS_END = WS_CARRY + 4 * MiB;

struct Params { const float* in[28]; float* out; unsigned char* ws; int ph_lo, ph_hi; };

struct Ctx {
    const float* in[28];
    float* out;
    bf16 *WABIN, *WABOUT, *WLIN, *WLOUT, *WLA, *WLX;
    float* X; bf16 *H, *O, *PROJ;
    bf16 *G_W, *G_QG, *G_KDT, *G_QK; float* G_UT;
    bf16 *L_QG, *L_KDT, *L_A, *L_VT; float *G_DEC, *L_DEC, *SUM, *SS; unsigned long long* CARRY;
    int G;
};

__device__ __forceinline__ int otid() { int t = threadIdx.x; asm volatile("" : "+v"(t)); return t; }
__device__ __forceinline__ int obid() { int b = blockIdx.x; asm volatile("" : "+s"(b)); return b; }
__device__ __forceinline__ float bf2f(unsigned b) { return __uint_as_float(b << 16); }
__device__ __forceinline__ unsigned f2bf(float f) { return (__float_as_uint(f) + 0x8000u) >> 16; }
__device__ __forceinline__ unsigned pk2(float lo, float hi) { return __builtin_amdgcn_perm(__float_as_uint(hi) + 0x8000u, __float_as_uint(lo) + 0x8000u, 0x07060302u); }
__device__ __forceinline__ void unpack8(v4u w, float (&f)[8]) {
    f[0] = __uint_as_float(w.x << 16); f[1] = __uint_as_float(w.x & 0xffff0000u);
    f[2] = __uint_as_float(w.y << 16); f[3] = __uint_as_float(w.y & 0xffff0000u);
    f[4] = __uint_as_float(w.z << 16); f[5] = __uint_as_float(w.z & 0xffff0000u);
    f[6] = __uint_as_float(w.w << 16); f[7] = __uint_as_float(w.w & 0xffff0000u);
}
__device__ __forceinline__ v4u pack8(const float (&f)[8]) { v4u w; w.x = pk2(f[0], f[1]); w.y = pk2(f[2], f[3]); w.z = pk2(f[4], f[5]); w.w = pk2(f[6], f[7]); return w; }
__device__ __forceinline__ float sigmoidf_(float x) { return __builtin_amdgcn_rcpf(1.0f + __expf(-x)); }
__device__ __forceinline__ float siluf_(float x) { return x * __builtin_amdgcn_rcpf(1.0f + __expf(-x)); }
#define LDS_BARRIER() do { asm volatile("s_waitcnt lgkmcnt(0)" ::: "memory"); __builtin_amdgcn_s_barrier(); asm volatile("" ::: "memory"); } while (0)
__device__ __forceinline__ float softplusf_(float x) { const float e = __expf(fminf(x, 20.f)); const float sp = (e < 0.03f) ? e * (1.0f - e * (0.5f - e * 0.33333333f)) : __logf(1.0f + e); return x > 20.f ? x : sp; }
__device__ __forceinline__ float logsigmoidf_(float x) { return fminf(x, 0.f) - __logf(1.0f + __expf(-fabsf(x))); }
__device__ __forceinline__ float wave_sum(float v) {
#pragma unroll
    for (int o = 1; o < 64; o <<= 1) v += __shfl_xor(v, o);
    return v;
}

__device__ __forceinline__ int frag_off(int row, int col, int nkk) { return (((row >> 4) * nkk + (col >> 5)) * 64 + ((col >> 3) & 3) * 16 + (row & 15)) * 8 + (col & 7); }
__device__ __forceinline__ int ufrag_off(int v, int c) { return (((v >> 4) * 4 + (c >> 4)) * 64 + ((c >> 2) & 3) * 16 + (v & 15)) * 4 + (c & 3); }
template <bool FRAG = false>
__device__ __forceinline__ void transpose_item(const float* W, int K, int N, bf16* WT, LAS float* scr, int item, int lane) {
    const int nblk = N / 32, kb = item / nblk, nb = item % nblk, k0 = 64 * kb, n0 = 32 * nb;
    float tv[32];
#pragma unroll
    for (int i = 0; i < 32; ++i) { const int kk = 2 * i + (lane >> 5); tv[i] = W[(size_t)(k0 + kk) * N + n0 + (lane & 31)]; }
#pragma unroll
    for (int i = 0; i < 32; ++i) { const int kk = 2 * i + (lane >> 5); scr[kk * 33 + (lane & 31)] = tv[i]; }
    asm volatile("s_waitcnt lgkmcnt(0)" ::: "memory");
    const int c = lane & 7;
#pragma unroll
    for (int j = 0; j < 4; ++j) { const int n = (lane >> 3) + 8 * j; const LAS float* s = scr + (8 * c) * 33 + n;
        v4u o; o.x = pk2(s[0 * 33], s[1 * 33]); o.y = pk2(s[2 * 33], s[3 * 33]); o.z = pk2(s[4 * 33], s[5 * 33]); o.w = pk2(s[6 * 33], s[7 * 33]);
        if (FRAG) *(v4u*)(WT + frag_off(n0 + n, k0 + 8 * c, K / 32)) = o;
        else *(v4u*)(WT + (size_t)(n0 + n) * K + k0 + 8 * c) = o; }
    asm volatile("s_waitcnt lgkmcnt(0)" ::: "memory");
}

__device__ __forceinline__ void rms_phase_bf16(const float* baseP, const float* baseS, const float* gw, bf16* Hout, int gwave, int ngw, int lane) {
    for (int m = gwave; m < NTOK; m += ngw) {
        const float* xr = (m < NPT) ? baseP + (size_t)m * DM : baseS + (size_t)(m - NPT) * DM;
        f32x4 v[8]; float ss = 0.f;
#pragma unroll
        for (int j = 0; j < 8; ++j) { v[j] = *(const f32x4*)(xr + (lane + 64 * j) * 4); ss += (v[j].x * v[j].x + v[j].y * v[j].y) + (v[j].z * v[j].z + v[j].w * v[j].w); }
        const float rinv = rsqrtf(wave_sum(ss) * (1.0f / DM) + EPS);
#pragma unroll
        for (int j = 0; j < 8; ++j) { const f32x4 g = *(const f32x4*)(gw + (lane + 64 * j) * 4);
            v2u o; o.x = pk2(v[j].x * rinv * g.x, v[j].y * rinv * g.y); o.y = pk2(v[j].z * rinv * g.z, v[j].w * rinv * g.w);
            *(v2u*)(Hout + (size_t)m * DM + (lane + 64 * j) * 4) = o; }
    }
}
__device__ __forceinline__ void rms_phase_f32(const float* X, const float* gw, float* out, int gwave, int ngw, int lane) {
    for (int m = gwave; m < NTOK; m += ngw) {
        const float* xr = X + (size_t)m * DM;
        f32x4 v[8]; float ss = 0.f;
#pragma unroll
        for (int j = 0; j < 8; ++j) { v[j] = *(const f32x4*)(xr + (lane + 64 * j) * 4); ss += (v[j].x * v[j].x + v[j].y * v[j].y) + (v[j].z * v[j].z + v[j].w * v[j].w); }
        const float rinv = rsqrtf(wave_sum(ss) * (1.0f / DM) + EPS);
#pragma unroll
        for (int j = 0; j < 8; ++j) { const f32x4 g = *(const f32x4*)(gw + (lane + 64 * j) * 4);
            f32x4 o; o.x = v[j].x * rinv * g.x; o.y = v[j].y * rinv * g.y; o.z = v[j].z * rinv * g.z; o.w = v[j].w * rinv * g.w;
            *(f32x4*)(out + (size_t)m * DM + (lane + 64 * j) * 4) = o; }
    }
}

constexpr int I_ABIN = 32 * 225, I_SQ = 32 * 64, I_LIN = 32 * 128, I_BLK = 2 * 4;
constexpr int OFF_ABOUT = 2 * I_ABIN, OFF_LIN = OFF_ABOUT + 2 * I_SQ, OFF_LOUT = OFF_LIN + 2 * I_LIN, OFF_WL = OFF_LOUT + 2 * I_SQ;
__device__ __forceinline__ void convert_item(const Ctx& C, int it, LAS float* scr, int lane) {
    int r = it;
    if (r < 2 * I_ABIN) { const int l = r / I_ABIN; r -= l * I_ABIN; transpose_item(C.in[8] + (size_t)l * 2048 * 7200, 2048, 7200, C.WABIN + (size_t)l * ABNP * 2048, scr, r, lane); return; } r -= 2 * I_ABIN;
    if (r < 2 * I_SQ) { const int l = r / I_SQ; r -= l * I_SQ; transpose_item(C.in[16] + (size_t)l * 2048 * 2048, 2048, 2048, C.WABOUT + (size_t)l * 2048 * 2048, scr, r, lane); return; } r -= 2 * I_SQ;
    if (r < 2 * I_LIN) { const int l = r / I_LIN; r -= l * I_LIN; transpose_item(C.in[18] + (size_t)l * 2048 * 4096, 2048, 4096, C.WLIN + (size_t)l * 4096 * 2048, scr, r, lane); return; } r -= 2 * I_LIN;
    if (r < 2 * I_SQ) { const int l = r / I_SQ; r -= l * I_SQ; transpose_item(C.in[26] + (size_t)l * 2048 * 2048, 2048, 2048, C.WLOUT + (size_t)l * 2048 * 2048, scr, r, lane); return; } r -= 2 * I_SQ;
    { const int which = r / (32 * I_BLK); r -= which * 32 * I_BLK; const int blk = r / I_BLK; r -= blk * I_BLK;
      transpose_item<true>((which ? C.in[23] : C.in[21]) + (size_t)blk * 16384, 128, 128, (which ? C.WLX : C.WLA) + (size_t)blk * 16384, scr, r, lane); }
}
__device__ __forceinline__ void convert_range(const Ctx& C, LAS float* scr, int lo, int hi, int wv, int nw, int lane) {
    if (wv < 0) return;
    for (int it = lo + wv; it < hi; it += nw) convert_item(C, it, scr, lane);
}
__device__ __forceinline__ void convert_segment(const Ctx& C, LAS unsigned char* lds, int seg, int first_idle_block) {
    const int tid = otid(), lane = tid & 63, wave = tid >> 6, bidx = obid();
    if (bidx < first_idle_block) return;
    LAS float* scr = (LAS float*)(lds + wave * 16384);
    const int wv = (bidx - first_idle_block) * 8 + wave, nw = (C.G - first_idle_block) * 8;
    if (seg == 1) {
        convert_range(C, scr, OFF_ABOUT, OFF_ABOUT + I_SQ, wv, nw, lane);
        convert_range(C, scr, OFF_LIN, OFF_LIN + I_LIN, wv, nw, lane);
        convert_range(C, scr, OFF_LOUT, OFF_LOUT + I_SQ, wv, nw, lane);
        convert_range(C, scr, OFF_WL, OFF_WL + 128, wv, nw, lane);
        convert_range(C, scr, OFF_WL + 256, OFF_WL + 384, wv, nw, lane);
    } else if (seg == 2) {
        convert_range(C, scr, I_ABIN, 2 * I_ABIN, wv, nw, lane);
    } else if (seg == 3) {
        convert_range(C, scr, OFF_ABOUT + I_SQ, OFF_ABOUT + 2 * I_SQ, wv, nw, lane);
        convert_range(C, scr, OFF_LIN + I_LIN, OFF_LIN + 2 * I_LIN, wv, nw, lane);
        convert_range(C, scr, OFF_WL + 128, OFF_WL + 256, wv, nw, lane);
        convert_range(C, scr, OFF_WL + 384, OFF_WL + 512, wv, nw, lane);
    } else {
        convert_range(C, scr, OFF_LOUT + I_SQ, OFF_LOUT + 2 * I_SQ, wv, nw, lane);
    }
}
__device__ __forceinline__ void prologue_phase(const Ctx& C, LAS unsigned char* lds) {
    const int tid = otid(), lane = tid & 63, wave = tid >> 6;
    LAS float* scr = (LAS float*)(lds + wave * 16384);
    const int bidx = obid(); const int gw = bidx * 8 + wave, NGW = C.G * 8;
    convert_range(C, scr, 0, (C.G == 256) ? I_ABIN : OFF_WL + 512, gw, NGW, lane);
    { const int gt = bidx * 512 + tid, ngt = C.G * 512; constexpr int PADV = 224 * 2048 / 8;
      for (int i = gt; i < 2 * PADV; i += ngt) { const int l = i / PADV, j = i % PADV; *(v4u*)(C.WABIN + (size_t)l * ABNP * 2048 + (size_t)7200 * 2048 + (size_t)j * 8) = (v4u){0u, 0u, 0u, 0u}; } }
    rms_phase_bf16(C.in[0], C.in[1], C.in[7], C.H, gw, NGW, lane);
}

__device__ __forceinline__ void gdn_prep_item(const Ctx& C, int layer, int item, LAS unsigned char* lds) {
    const int tid = otid(), lane = tid & 63, wid = tid >> 6, l15 = lane & 15, quad = lane >> 4;
    const int n = item & 31, h = (item >> 5) & 7, b = item >> 8;
    const size_t ch = (size_t)n * 32 + (item >> 5);
    LAS float* sQ = (LAS float*)lds;
    LAS float* sK = sQ + 64 * 132;
    LAS float* sV = sK + 64 * 132;
    LAS float* sA = sV + 64 * 132;
    LAS float* sBeta = sA + 64 * 64;
    LAS float* sG = sBeta + 64;
    LAS bf16* sQKb = (LAS bf16*)(sG + 64);
    const bf16* proj = C.PROJ;
    const float* cw = C.in[9] + (size_t)layer * 4 * 3072;
#pragma unroll 2
    for (int idx = tid; idx < 3072; idx += 512) {
        const int r = idx / 48, cg = idx % 48, part = cg >> 4, c8 = (cg & 15) * 8;
        const int col = part * 1024 + h * 128 + c8;
        float acc[8];
#pragma unroll
        for (int e = 0; e < 8; ++e) acc[e] = 0.f;
#pragma unroll
        for (int j = 0; j < 4; ++j) {
            const int t = n * 64 + r - 3 + j;
            if (t >= 0) {
                const v4u w = *(const v4u*)(proj + (size_t)(b * TP + t) * ABNP + col);
                float x[8]; unpack8(w, x);
                const f32x4 w0 = *(const f32x4*)(cw + j * 3072 + col), w1 = *(const f32x4*)(cw + j * 3072 + col + 4);
                acc[0] += x[0] * w0.x; acc[1] += x[1] * w0.y; acc[2] += x[2] * w0.z; acc[3] += x[3] * w0.w;
                acc[4] += x[4] * w1.x; acc[5] += x[5] * w1.y; acc[6] += x[6] * w1.z; acc[7] += x[7] * w1.w;
                if (j == 3 && n == 31 && r >= 61) {
                    float* o = C.out + O_PDCONV + ((size_t)(layer * 4 + b) * 3 + (r - 61)) * 3072 + col;
                    *(f32x4*)o = (f32x4){x[0], x[1], x[2], x[3]}; *(f32x4*)(o + 4) = (f32x4){x[4], x[5], x[6], x[7]};
                }
            }
        }
        LAS float* dst = (part == 0 ? sQ : (part == 1 ? sK : sV)) + r * 132 + c8;
        *(LAS f32x4*)dst = (f32x4){siluf_(acc[0]), siluf_(acc[1]), siluf_(acc[2]), siluf_(acc[3])};
        *(LAS f32x4*)(dst + 4) = (f32x4){siluf_(acc[4]), siluf_(acc[5]), siluf_(acc[6]), siluf_(acc[7])};
    }
    __syncthreads();
#pragma unroll
    for (int rr = 0; rr < 8; ++rr) {
        const int r = wid * 8 + rr;
        { const float a0 = sQ[r * 132 + lane], a1 = sQ[r * 132 + 64 + lane]; const float sc = rsqrtf(wave_sum(a0 * a0 + a1 * a1) + EPS) * 0.08838834764831845f;
          sQ[r * 132 + lane] = a0 * sc; sQ[r * 132 + 64 + lane] = a1 * sc; }
        { const float a0 = sK[r * 132 + lane], a1 = sK[r * 132 + 64 + lane]; const float sc = rsqrtf(wave_sum(a0 * a0 + a1 * a1) + EPS);
          sK[r * 132 + lane] = a0 * sc; sK[r * 132 + 64 + lane] = a1 * sc; }
    }
    if (tid < 64) {
        const size_t row = (size_t)(b * TP + n * 64 + tid);
        const float braw = bf2f(proj[row * ABNP + C_BRAW + h]), araw = bf2f(proj[row * ABNP + C_ARAW + h]);
        const float beta = sigmoidf_(braw);
        float g = -__expf(C.in[10][layer * 8 + h]) * softplusf_(araw + C.in[11][layer * 8 + h]);
#pragma unroll
        for (int o = 1; o < 64; o <<= 1) { const float t = __shfl_up(g, o); if (lane >= o) g += t; }
        sBeta[tid] = beta; sG[tid] = g;
    }
    __syncthreads();
    {
        const int mi = wid >> 1;
#pragma unroll
        for (int tt = 0; tt < 2; ++tt) {
            const int nj = (wid & 1) * 2 + tt;
            f32x4 accA = {0.f, 0.f, 0.f, 0.f}, accQ = {0.f, 0.f, 0.f, 0.f};
            if (nj <= mi) {
#pragma unroll
                for (int k16 = 0; k16 < 8; ++k16) {
                    const f32x4 ka = *(const LAS f32x4*)(sK + (mi * 16 + l15) * 132 + k16 * 16 + quad * 4);
                    const f32x4 qa = *(const LAS f32x4*)(sQ + (mi * 16 + l15) * 132 + k16 * 16 + quad * 4);
                    const f32x4 kb = *(const LAS f32x4*)(sK + (nj * 16 + l15) * 132 + k16 * 16 + quad * 4);
#pragma unroll
                    for (int s = 0; s < 4; ++s) {
                        accA = __builtin_amdgcn_mfma_f32_16x16x4f32(ka[s], kb[s], accA, 0, 0, 0);
                        accQ = __builtin_amdgcn_mfma_f32_16x16x4f32(qa[s], kb[s], accQ, 0, 0, 0);
                    }
                }
            }
            const int j = nj * 16 + l15; const float Gj = sG[j];
            f32x4 av;
#pragma unroll
            for (int jj = 0; jj < 4; ++jj) {
                const int i = mi * 16 + quad * 4 + jj;
                const float dec = (i >= j) ? __expf(sG[i] - Gj) : 0.f;
                av[jj] = (i > j) ? sBeta[i] * accA[jj] * dec : 0.f;
                sQKb[i * 72 + j] = (bf16)f2bf((i >= j) ? accQ[jj] * dec : 0.f);
            }
            if (nj <= mi) *(LAS f32x4*)(sA + j * 64 + mi * 16 + quad * 4) = av;
        }
    }
    __syncthreads();
    {
        const float gl = sG[63];
        for (int idx = tid; idx < 1024; idx += 512) {
            const int r = (idx >> 8) * 16 + (idx & 15), c8 = ((idx >> 6) & 3) * 32 + ((idx >> 4) & 3) * 8; const float eg = __expf(sG[r]);
            float v[8];
#pragma unroll
            for (int e = 0; e < 8; ++e) v[e] = sQ[r * 132 + c8 + e] * eg;
            *(v4u*)(C.G_QG + ch * 8192 + idx * 8) = pack8(v);
        }
        for (int idx = tid; idx < 1024; idx += 512) {
            const int k = (idx >> 7) * 16 + (idx & 15), i8 = ((idx >> 6) & 1) * 32 + ((idx >> 4) & 3) * 8;
            float v[8];
#pragma unroll
            for (int e = 0; e < 8; ++e) v[e] = sK[(i8 + e) * 132 + k] * __expf(gl - sG[i8 + e]);
            *(v4u*)(C.G_KDT + ch * 8192 + idx * 8) = pack8(v);
        }
        { const int idx = tid;
          const int r = (idx >> 7) * 16 + (idx & 15), c8 = ((idx >> 6) & 1) * 32 + ((idx >> 4) & 3) * 8;
          *(v4u*)(C.G_QK + ch * 4096 + idx * 8) = *(const LAS v4u*)(sQKb + r * 72 + c8); }
        if (tid == 0) C.G_DEC[ch] = __expf(gl);
    }
    __syncthreads();
    if (tid < 256) {
        const int c = tid;
        LAS float* colp = (c < 128) ? (sV + c) : (sK + (c - 128));
#pragma unroll 1
        for (int I = 0; I < 4; ++I) {
            float sl[16];
#pragma unroll
            for (int ii = 0; ii < 16; ++ii) { const int i = I * 16 + ii; const float f = (c < 128) ? sBeta[i] : sBeta[i] * __expf(sG[i]); sl[ii] = colp[i * 132] * f; }
#pragma unroll 4
            for (int j = 0; j < I * 16; ++j) {
                const float x = colp[j * 132];
                const LAS float* ap = sA + j * 64 + I * 16;
                const f32x4 a0 = *(const LAS f32x4*)ap, a1 = *(const LAS f32x4*)(ap + 4), a2 = *(const LAS f32x4*)(ap + 8), a3 = *(const LAS f32x4*)(ap + 12);
                sl[0] -= a0.x * x; sl[1] -= a0.y * x; sl[2] -= a0.z * x; sl[3] -= a0.w * x;
                sl[4] -= a1.x * x; sl[5] -= a1.y * x; sl[6] -= a1.z * x; sl[7] -= a1.w * x;
                sl[8] -= a2.x * x; sl[9] -= a2.y * x; sl[10] -= a2.z * x; sl[11] -= a2.w * x;
                sl[12] -= a3.x * x; sl[13] -= a3.y * x; sl[14] -= a3.z * x; sl[15] -= a3.w * x;
            }
#pragma unroll
            for (int jj = 0; jj < 15; ++jj) {
                const LAS float* ap = sA + (I * 16 + jj) * 64 + I * 16;
                float a[16];
#pragma unroll
                for (int q4 = 0; q4 < 4; ++q4) { const f32x4 t = *(const LAS f32x4*)(ap + q4 * 4); a[q4 * 4] = t.x; a[q4 * 4 + 1] = t.y; a[q4 * 4 + 2] = t.z; a[q4 * 4 + 3] = t.w; }
#pragma unroll
                for (int ii = jj + 1; ii < 16; ++ii) sl[ii] -= a[ii] * sl[jj];
            }
#pragma unroll
            for (int ii = 0; ii < 16; ++ii) colp[(I * 16 + ii) * 132] = sl[ii];
        }
    }
    __syncthreads();
    for (int idx = tid; idx < 1024; idx += 512) {
        const int r = (idx >> 8) * 16 + (idx & 15), c8 = ((idx >> 6) & 3) * 32 + ((idx >> 4) & 3) * 8;
        float v[8];
#pragma unroll
        for (int e = 0; e < 8; ++e) v[e] = sK[r * 132 + c8 + e];
        *(v4u*)(C.G_W + ch * 8192 + idx * 8) = pack8(v);
    }
    for (int idx = tid; idx < 2048; idx += 512) {
        const int v = (idx >> 8) * 16 + (idx & 15), c = ((idx >> 6) & 3) * 16 + ((idx >> 4) & 3) * 4;
        *(f32x4*)(C.G_UT + ch * 8192 + idx * 4) = (f32x4){sV[c * 132 + v], sV[(c + 1) * 132 + v], sV[(c + 2) * 132 + v], sV[(c + 3) * 132 + v]};
    }
    __syncthreads();
}

__device__ __forceinline__ void gla_prep_item(const Ctx& C, int layer, int item, LAS unsigned char* lds) {
    const int tid = otid(), lane = tid & 63, wid = tid >> 6, l15 = lane & 15, quad = lane >> 4;
    const int n = item & 31, h = (item >> 5) & 3, b = item >> 7;
    const size_t ch = (size_t)n * 16 + (item >> 5);
    const size_t tok0 = (size_t)b * TP + n * 64;
    LAS float* sQG = (LAS float*)lds;
    LAS float* sKN = sQG + 64 * 132;
    LAS float* sBc = sKN + 64 * 132;
    LAS float* sLR = sBc + 64 * 132;
    LAS bf16* sAb = (LAS bf16*)(sLR + 1024);
    const bf16* proj = C.PROJ;
    for (int idx = tid; idx < 1024; idx += 512) { const int r = idx >> 4, m = idx & 15; sLR[idx] = bf2f(proj[(tok0 + r) * ABNP + C_LR + m]); }
    __syncthreads();
    {
        const int k = tid & 127, rg = tid >> 7;
        float wl[16];
#pragma unroll
        for (int m = 0; m < 16; ++m) wl[m] = C.in[13][(size_t)(layer * 16 + m) * 512 + h * 128 + k];
        const float bl = C.in[14][layer * 512 + h * 128 + k];
        for (int r = rg * 16; r < rg * 16 + 16; ++r) {
            float x = bl;
#pragma unroll
            for (int m = 0; m < 16; ++m) x += sLR[r * 16 + m] * wl[m];
            sBc[r * 132 + k] = logsigmoidf_(x) * (1.0f / 16.0f);
        }
    }
    __syncthreads();
    if (tid < 128) { float acc = 0.f;
#pragma unroll 16
        for (int r = 0; r < 64; ++r) { acc += sBc[r * 132 + tid]; sBc[r * 132 + tid] = acc; } }
    __syncthreads();
    for (int idx = tid; idx < 1024; idx += 512) {
        const int r = idx >> 4, c8 = (idx & 15) * 8;
        float q[8], k[8], qg[8];
        unpack8(*(const v4u*)(proj + (tok0 + r) * ABNP + C_QB + h * 128 + c8), q);
        unpack8(*(const v4u*)(proj + (tok0 + r) * ABNP + C_KB + h * 128 + c8), k);
#pragma unroll
        for (int e = 0; e < 8; ++e) { const float bc = sBc[r * 132 + c8 + e]; qg[e] = q[e] * 0.08838834764831845f * __expf(bc); sQG[r * 132 + c8 + e] = qg[e]; sKN[r * 132 + c8 + e] = k[e] * __expf(-bc); }
    }
    for (int idx = tid; idx < 2048; idx += 512) {
        const int v = idx & 255, i8 = (idx >> 8) * 8;
        float x[8];
#pragma unroll
        for (int e = 0; e < 8; ++e) x[e] = bf2f(proj[(tok0 + i8 + e) * ABNP + C_VB + h * 256 + v]);
        *(v4u*)(C.L_VT + ch * 16384 + frag_off(v, i8, 2)) = pack8(x);
    }
    __syncthreads();
    for (int idx = tid; idx < 1024; idx += 512) {
        const int r = (idx >> 8) * 16 + (idx & 15), c8 = ((idx >> 6) & 3) * 32 + ((idx >> 4) & 3) * 8;
        float v[8];
#pragma unroll
        for (int e = 0; e < 8; ++e) v[e] = sQG[r * 132 + c8 + e];
        *(v4u*)(C.L_QG + ch * 8192 + idx * 8) = pack8(v);
    }
    for (int idx = tid; idx < 1024; idx += 512) {
        const int k = (idx >> 7) * 16 + (idx & 15), i8 = ((idx >> 6) & 1) * 32 + ((idx >> 4) & 3) * 8; const float ebl = __expf(sBc[63 * 132 + k]);
        float v[8];
#pragma unroll
        for (int e = 0; e < 8; ++e) v[e] = sKN[(i8 + e) * 132 + k] * ebl;
        *(v4u*)(C.L_KDT + ch * 8192 + idx * 8) = pack8(v);
    }
    if (tid < 128) C.L_DEC[ch * 128 + tid] = __expf(sBc[63 * 132 + tid]);
    {
        const int mi = wid >> 1;
#pragma unroll
        for (int tt = 0; tt < 2; ++tt) {
            const int nj = (wid & 1) * 2 + tt;
            f32x4 acc = {0.f, 0.f, 0.f, 0.f};
            if (nj <= mi) {
#pragma unroll
                for (int k16 = 0; k16 < 8; ++k16) {
                    const f32x4 qa = *(const LAS f32x4*)(sQG + (mi * 16 + l15) * 132 + k16 * 16 + quad * 4);
                    const f32x4 kb = *(const LAS f32x4*)(sKN + (nj * 16 + l15) * 132 + k16 * 16 + quad * 4);
#pragma unroll
                    for (int s = 0; s < 4; ++s) acc = __builtin_amdgcn_mfma_f32_16x16x4f32(qa[s], kb[s], acc, 0, 0, 0);
                }
            }
            const int j = nj * 16 + l15;
#pragma unroll
            for (int jj = 0; jj < 4; ++jj) { const int i = mi * 16 + quad * 4 + jj; sAb[i * 72 + j] = (bf16)f2bf((i >= j) ? acc[jj] : 0.f); }
        }
    }
    __syncthreads();
    { const int idx = tid;
      const int r = (idx >> 7) * 16 + (idx & 15), c8 = ((idx >> 6) & 1) * 32 + ((idx >> 4) & 3) * 8;
      *(v4u*)(C.L_A + ch * 4096 + idx * 8) = *(const LAS v4u*)(sAb + r * 72 + c8); }
    __syncthreads();
}

template <bool HAS_W> struct ScanFr { bf16x8 aq[4]; bf16x8 aw[4]; bf16x8 aqk[2]; bf16x8 ak[2][2]; bf16x8 bvg[2]; f32x4 u; f32x4 dec[2]; };
template <bool HAS_W>
__device__ __forceinline__ void scan_load(ScanFr<HAS_W>& F, const Ctx& C, size_t ch, int s, int mi, int ni, int kt0, int l15, int quad) {
    const int lane8 = (quad * 16 + l15) * 8;
    const bf16* QG = (HAS_W ? C.G_QG : C.L_QG) + ch * 8192 + lane8;
    const bf16* KDT = (HAS_W ? C.G_KDT : C.L_KDT) + ch * 8192 + lane8;
    const bf16* QK = (HAS_W ? C.G_QK : C.L_A) + ch * 4096 + lane8;
#pragma unroll
    for (int kk = 0; kk < 4; ++kk) {
        F.aq[kk] = *(const bf16x8*)(QG + (mi * 4 + kk) * 512);
        if (HAS_W) F.aw[kk] = *(const bf16x8*)(C.G_W + ch * 8192 + lane8 + (mi * 4 + kk) * 512);
    }
#pragma unroll
    for (int kk = 0; kk < 2; ++kk) {
        F.aqk[kk] = *(const bf16x8*)(QK + (mi * 2 + kk) * 512);
#pragma unroll
        for (int t = 0; t < 2; ++t) F.ak[t][kk] = *(const bf16x8*)(KDT + ((kt0 + t) * 2 + kk) * 512);
        if (!HAS_W) F.bvg[kk] = *(const bf16x8*)(C.L_VT + ch * 16384 + lane8 + ((s * 2 + ni) * 2 + kk) * 512);
    }
    if (HAS_W) {
        F.u = *(const f32x4*)(C.G_UT + ch * 8192 + (((s * 2 + ni) * 4 + mi) * 64 + quad * 16 + l15) * 4);
        const float d = C.G_DEC[ch]; F.dec[0] = (f32x4){d, d, d, d}; F.dec[1] = F.dec[0];
    } else {
#pragma unroll
        for (int t = 0; t < 2; ++t) F.dec[t] = *(const f32x4*)(C.L_DEC + ch * 128 + (kt0 + t) * 16 + quad * 4);
    }
}
template <bool HAS_W>
__device__ __forceinline__ void scan_step(const ScanFr<HAS_W>& F, f32x4 (&Sacc)[2], LAS bf16* sST, LAS bf16* sVT, LAS bf16* sO, int mi, int ni, int kt0, int l15, int quad) {
    f32x4 acc_o = {0.f, 0.f, 0.f, 0.f}, acc_w = {0.f, 0.f, 0.f, 0.f};
#pragma unroll
    for (int kk = 0; kk < 4; ++kk) {
        const bf16x8 bfr = *(const LAS bf16x8*)(sST + (ni * 16 + l15) * 136 + kk * 32 + quad * 8);
        acc_o = __builtin_amdgcn_mfma_f32_16x16x32_bf16(F.aq[kk], bfr, acc_o, 0, 0, 0);
        if (HAS_W) acc_w = __builtin_amdgcn_mfma_f32_16x16x32_bf16(F.aw[kk], bfr, acc_w, 0, 0, 0);
    }
    if (HAS_W) {
        const f32x4 vn = F.u - acc_w;
        v2u o; o.x = pk2(vn.x, vn.y); o.y = pk2(vn.z, vn.w);
        *(LAS v2u*)(sVT + (ni * 16 + l15) * 72 + mi * 16 + quad * 4) = o;
    }
    LDS_BARRIER();
    bf16x8 bv[2];
#pragma unroll
    for (int kk = 0; kk < 2; ++kk) {
        if (HAS_W) bv[kk] = *(const LAS bf16x8*)(sVT + (ni * 16 + l15) * 72 + kk * 32 + quad * 8);
        else bv[kk] = F.bvg[kk];
    }
#pragma unroll
    for (int kk = 0; kk < 2; ++kk) acc_o = __builtin_amdgcn_mfma_f32_16x16x32_bf16(F.aqk[kk], bv[kk], acc_o, 0, 0, 0);
#pragma unroll
    for (int j = 0; j < 4; ++j) sO[(mi * 16 + quad * 4 + j) * 40 + ni * 16 + l15] = (bf16)f2bf(acc_o[j]);
#pragma unroll
    for (int t = 0; t < 2; ++t) {
        Sacc[t] = Sacc[t] * F.dec[t];
#pragma unroll
        for (int kk = 0; kk < 2; ++kk) Sacc[t] = __builtin_amdgcn_mfma_f32_16x16x32_bf16(F.ak[t][kk], bv[kk], Sacc[t], 0, 0, 0);
        v2u o; o.x = pk2(Sacc[t].x, Sacc[t].y); o.y = pk2(Sacc[t].z, Sacc[t].w);
        *(LAS v2u*)(sST + (ni * 16 + l15) * 136 + (kt0 + t) * 16 + quad * 4) = o;
    }
    LDS_BARRIER();
}
template <bool HAS_W>
__device__ __forceinline__ void scan_task(const Ctx& C, int layer, int task, LAS unsigned char* lds) {
    const int tid = otid(), lane = tid & 63, w = tid >> 6, l15 = lane & 15, quad = lane >> 4;
    const int s = HAS_W ? (task & 3) : (task & 7), bh = HAS_W ? (task >> 2) : (task >> 3);
    const int b = HAS_W ? (bh >> 3) : (bh >> 2), h = HAS_W ? (bh & 7) : (bh & 3);
    const int mi = w >> 1, ni = w & 1, kt0 = (w >> 1) * 2;
    LAS bf16* sST = (LAS bf16*)lds;
    LAS bf16* sVT = sST + 32 * 136;
    LAS bf16* sO = sVT + 32 * 72;
    f32x4 Sacc[2]; Sacc[0] = (f32x4){0.f, 0.f, 0.f, 0.f}; Sacc[1] = Sacc[0];
    for (int i = tid; i < 32 * 136 / 2; i += 512) ((LAS unsigned*)sST)[i] = 0u;
    const int colbase = HAS_W ? (h * 128 + s * 32) : (1024 + h * 256 + s * 32);
    bf16* OA = C.H + (size_t)b * TP * DM + colbase;
    const int NBH = HAS_W ? 32 : 16;
    ScanFr<HAS_W> FA, FB;
    __syncthreads();
#pragma unroll 1
    for (int n = 0; n < 32; n += 2) {
        scan_load<HAS_W>(FA, C, (size_t)n * NBH + bh, s, mi, ni, kt0, l15, quad);
        scan_load<HAS_W>(FB, C, (size_t)(n + 1) * NBH + bh, s, mi, ni, kt0, l15, quad);
        scan_step<HAS_W>(FA, Sacc, sST, sVT, sO, mi, ni, kt0, l15, quad);
        scan_step<HAS_W>(FB, Sacc, sST, sVT, sO + 64 * 40, mi, ni, kt0, l15, quad);
        {
            const int r = tid >> 2, sgm = tid & 3;
            const v4u ov = *(const LAS v4u*)(sO + r * 40 + sgm * 8);
            *(v4u*)(OA + (size_t)(n * 64 + r) * DM + sgm * 8) = ov;
        }
    }
    const int DV = HAS_W ? 128 : 256;
    float* outS = C.out + (HAS_W ? O_PDELTA + (size_t)((layer * 4 + b) * 8 + h) * 128 * 128 : O_PGLA + (size_t)((layer * 4 + b) * 4 + h) * 128 * 256);
#pragma unroll
    for (int t = 0; t < 2; ++t)
#pragma unroll
        for (int j = 0; j < 4; ++j) outS[(size_t)((kt0 + t) * 16 + quad * 4 + j) * DV + s * 32 + ni * 16 + l15] = Sacc[t][j];
    __syncthreads();
}

__device__ __forceinline__ void gdn_sample_item(const Ctx& C, int layer, int item, LAS unsigned char* lds) {
    const int tid = otid(), lane = tid & 63, wid = tid >> 6;
    const int h = item & 7, b = item >> 3;
    LAS float* sq = (LAS float*)lds;
    LAS float* sk = sq + 1024;
    LAS float* sv = sk + 1024;
    LAS float* so = sv + 1024;
    LAS float* red = so + 1024;
    LAS float* red2 = red + 512;
    LAS float* sbeta = red2 + 512;
    LAS float* seg = sbeta + 8;
    const bf16* proj = C.PROJ;
    const size_t tokS = (size_t)NPT + b * 8;
    const float* cw = C.in[9] + (size_t)layer * 4 * 3072;
    if (tid < 384) {
        const int t = tid / 48, cg = tid % 48, part = cg >> 4, c8 = (cg & 15) * 8;
        const int col = part * 1024 + h * 128 + c8;
        float acc[8];
#pragma unroll
        for (int e = 0; e < 8; ++e) acc[e] = 0.f;
#pragma unroll
        for (int j = 0; j < 4; ++j) {
            const int tl = t - 3 + j;
            float x[8];
            if (tl >= 0) unpack8(*(const v4u*)(proj + (tokS + tl) * ABNP + col), x);
            else { const float* sp = C.in[3] + ((size_t)(layer * 128 + b) * 3 + (3 + tl)) * 3072 + col;
                const f32x4 a = *(const f32x4*)sp, c = *(const f32x4*)(sp + 4); x[0] = a.x; x[1] = a.y; x[2] = a.z; x[3] = a.w; x[4] = c.x; x[5] = c.y; x[6] = c.z; x[7] = c.w; }
            const f32x4 w0 = *(const f32x4*)(cw + j * 3072 + col), w1 = *(const f32x4*)(cw + j * 3072 + col + 4);
            acc[0] += x[0] * w0.x; acc[1] += x[1] * w0.y; acc[2] += x[2] * w0.z; acc[3] += x[3] * w0.w;
            acc[4] += x[4] * w1.x; acc[5] += x[5] * w1.y; acc[6] += x[6] * w1.z; acc[7] += x[7] * w1.w;
            if (j == 3 && t >= 5) {
                float* o = C.out + O_SDCONV + ((size_t)(layer * 128 + b) * 3 + (t - 5)) * 3072 + col;
                *(f32x4*)o = (f32x4){x[0], x[1], x[2], x[3]}; *(f32x4*)(o + 4) = (f32x4){x[4], x[5], x[6], x[7]};
            }
        }
        LAS float* dst = (part == 0 ? sq : (part == 1 ? sk : sv)) + t * 128 + c8;
        *(LAS f32x4*)dst = (f32x4){siluf_(acc[0]), siluf_(acc[1]), siluf_(acc[2]), siluf_(acc[3])};
        *(LAS f32x4*)(dst + 4) = (f32x4){siluf_(acc[4]), siluf_(acc[5]), siluf_(acc[6]), siluf_(acc[7])};
    }
    __syncthreads();
    {
        const int r = wid;
        { const float a0 = sq[r * 128 + lane], a1 = sq[r * 128 + 64 + lane]; const float sc = rsqrtf(wave_sum(a0 * a0 + a1 * a1) + EPS) * 0.08838834764831845f;
          sq[r * 128 + lane] = a0 * sc; sq[r * 128 + 64 + lane] = a1 * sc; }
        { const float a0 = sk[r * 128 + lane], a1 = sk[r * 128 + 64 + lane]; const float sc = rsqrtf(wave_sum(a0 * a0 + a1 * a1) + EPS);
          sk[r * 128 + lane] = a0 * sc; sk[r * 128 + 64 + lane] = a1 * sc; }
        if (tid < 8) {
            const float braw = bf2f(proj[(tokS + tid) * ABNP + C_BRAW + h]), araw = bf2f(proj[(tokS + tid) * ABNP + C_ARAW + h]);
            sbeta[tid] = sigmoidf_(braw);
            seg[tid] = __expf(-__expf(C.in[10][layer * 8 + h]) * softplusf_(araw + C.in[11][layer * 8 + h]));
        }
    }
    const int v = tid & 127, kg = tid >> 7;
    float S[32];
    { const float* sp = C.in[2] + ((size_t)((layer * 128 + b) * 8 + h) * 128 + kg * 32) * 128 + v;
#pragma unroll
      for (int i = 0; i < 32; ++i) S[i] = sp[(size_t)i * 128]; }
    __syncthreads();
    for (int t = 0; t < 8; ++t) {
        const float eg = seg[t];
        float p = 0.f;
#pragma unroll
        for (int i = 0; i < 32; ++i) p += S[i] * sk[t * 128 + kg * 32 + i];
        red[kg * 128 + v] = p;
        __syncthreads();
        const float r = (red[v] + red[128 + v]) + (red[256 + v] + red[384 + v]);
        const float vn = sbeta[t] * (sv[t * 128 + v] - eg * r);
        float po = 0.f;
#pragma unroll
        for (int i = 0; i < 32; ++i) { S[i] = eg * S[i] + sk[t * 128 + kg * 32 + i] * vn; po += S[i] * sq[t * 128 + kg * 32 + i]; }
        red2[kg * 128 + v] = po;
        __syncthreads();
        if (kg == 0) so[t * 128 + v] = (red2[v] + red2[128 + v]) + (red2[256 + v] + red2[384 + v]);
    }
    { float* op = C.out + O_SDELTA + ((size_t)((layer * 128 + b) * 8 + h) * 128 + kg * 32) * 128 + v;
#pragma unroll
      for (int i = 0; i < 32; ++i) op[(size_t)i * 128] = S[i]; }
    __syncthreads();
    {
        const int t = wid;
        const float o0 = so[t * 128 + lane], o1 = so[t * 128 + 64 + lane];
        const float rstd = rsqrtf(wave_sum(o0 * o0 + o1 * o1) * (1.0f / 128.0f) + EPS);
        const float* nw = C.in[12] + layer * 128;
        const float z0 = bf2f(proj[(tokS + t) * ABNP + C_ZA + h * 128 + lane]), z1 = bf2f(proj[(tokS + t) * ABNP + C_ZA + h * 128 + 64 + lane]);
        C.O[(tokS + t) * DM + h * 128 + lane] = (bf16)f2bf(o0 * rstd * nw[lane] * siluf_(z0));
        C.O[(tokS + t) * DM + h * 128 + 64 + lane] = (bf16)f2bf(o1 * rstd * nw[64 + lane] * siluf_(z1));
    }
    __syncthreads();
}

__device__ __forceinline__ void gla_sample_item(const Ctx& C, int layer, int item, LAS unsigned char* lds) {
    const int tid = otid(), lane = tid & 63, wid = tid >> 6;
    const int h = item & 3, b = item >> 2;
    LAS float* sq = (LAS float*)lds;
    LAS float* sk = sq + 1024;
    LAS float* sgk = sk + 1024;
    LAS float* sv = sgk + 1024;
    LAS float* so = sv + 2048;
    LAS float* red = so + 2048;
    LAS float* slr = red + 4096;
    const bf16* proj = C.PROJ;
    const size_t tokS = (size_t)NPT + b * 8;
    if (tid < 128) slr[tid] = bf2f(proj[(tokS + (tid >> 4)) * ABNP + C_LR + (tid & 15)]);
    for (int idx = tid; idx < 1024; idx += 512) { const int t = idx >> 7, k = idx & 127;
        sq[idx] = bf2f(proj[(tokS + t) * ABNP + C_QB + h * 128 + k]) * 0.08838834764831845f; sk[idx] = bf2f(proj[(tokS + t) * ABNP + C_KB + h * 128 + k]); }
    for (int idx = tid; idx < 2048; idx += 512) { const int t = idx >> 8, vv = idx & 255; sv[idx] = bf2f(proj[(tokS + t) * ABNP + C_VB + h * 256 + vv]); }
    __syncthreads();
    for (int idx = tid; idx < 1024; idx += 512) { const int t = idx >> 7, k = idx & 127;
        float x = C.in[14][layer * 512 + h * 128 + k];
#pragma unroll
        for (int m = 0; m < 16; ++m) x += slr[t * 16 + m] * C.in[13][(size_t)(layer * 16 + m) * 512 + h * 128 + k];
        sgk[idx] = __expf(logsigmoidf_(x) * (1.0f / 16.0f)); }
    const int v4 = (tid & 63) * 4, k0 = (tid >> 6) * 16;
    f32x4 S[16];
    { const float* sp = C.in[4] + ((size_t)((layer * 128 + b) * 4 + h) * 128 + k0) * 256 + v4;
#pragma unroll
      for (int i = 0; i < 16; ++i) S[i] = *(const f32x4*)(sp + (size_t)i * 256); }
    __syncthreads();
    LAS float* red8 = red;
    for (int t = 0; t < 8; ++t) {
        const f32x4 vt = *(const LAS f32x4*)(sv + t * 256 + v4);
        f32x4 po = {0.f, 0.f, 0.f, 0.f};
#pragma unroll
        for (int i4 = 0; i4 < 4; ++i4) {
            const f32x4 g4 = *(const LAS f32x4*)(sgk + t * 128 + k0 + i4 * 4), kk4 = *(const LAS f32x4*)(sk + t * 128 + k0 + i4 * 4), q4 = *(const LAS f32x4*)(sq + t * 128 + k0 + i4 * 4);
#pragma unroll
            for (int e = 0; e < 4; ++e) { const int i = i4 * 4 + e; S[i] = S[i] * g4[e] + vt * kk4[e]; po = po + S[i] * q4[e]; }
        }
        *(LAS f32x4*)(red8 + (t & 1) * 2048 + (tid >> 6) * 256 + v4) = po;
        __syncthreads();
        if (tid < 256) { float a = 0.f;
#pragma unroll
            for (int g = 0; g < 8; ++g) a += red8[(t & 1) * 2048 + g * 256 + tid];
            so[t * 256 + tid] = a; }
    }
    { float* op = C.out + O_SGLA + ((size_t)((layer * 128 + b) * 4 + h) * 128 + k0) * 256 + v4;
#pragma unroll
      for (int i = 0; i < 16; ++i) *(f32x4*)(op + (size_t)i * 256) = S[i]; }
    __syncthreads();
    {
        const int t = wid;
        float o[4], ss = 0.f;
#pragma unroll
        for (int e = 0; e < 4; ++e) { o[e] = so[t * 256 + e * 64 + lane]; ss += o[e] * o[e]; }
        const float rstd = rsqrtf(wave_sum(ss) * (1.0f / 256.0f) + EPS);
        const float* nw = C.in[15] + layer * 256;
#pragma unroll
        for (int e = 0; e < 4; ++e) { const int vv = e * 64 + lane; const float z = bf2f(proj[(tokS + t) * ABNP + C_ZB + h * 256 + vv]);
            C.O[(tokS + t) * DM + 1024 + h * 256 + vv] = (bf16)f2bf(o[e] * rstd * nw[vv] * siluf_(z)); }
    }
    __syncthreads();
}

__device__ __forceinline__ void gatenorm_phase(const Ctx& C, int layer, int gwave, int ngw, int lane) {
    const bf16* OA = C.H;
    for (int m = gwave; m < NPT; m += ngw) {
#pragma unroll
        for (int st = 0; st < 4; ++st) {
            const int c0 = st * 512 + lane * 8;
            float o[8], z[8];
            unpack8(*(const v4u*)(OA + (size_t)m * DM + c0), o);
            const bool gdn = st < 2;
            const int zc = gdn ? (C_ZA + c0) : (C_ZB + (c0 - 1024));
            unpack8(*(const v4u*)(C.PROJ + (size_t)m * ABNP + zc), z);
            float ss = 0.f;
#pragma unroll
            for (int e = 0; e < 8; ++e) ss += o[e] * o[e];
            ss += __shfl_xor(ss, 1); ss += __shfl_xor(ss, 2); ss += __shfl_xor(ss, 4); ss += __shfl_xor(ss, 8);
            if (!gdn) ss += __shfl_xor(ss, 16);
            const float rstd = rsqrtf(ss * (gdn ? (1.0f / 128.0f) : (1.0f / 256.0f)) + EPS);
            const float* nw = gdn ? (C.in[12] + layer * 128 + (c0 & 127)) : (C.in[15] + layer * 256 + ((c0 - 1024) & 255));
            const f32x4 n0 = *(const f32x4*)nw, n1 = *(const f32x4*)(nw + 4);
            float r[8];
            r[0] = o[0] * rstd * n0.x * siluf_(z[0]); r[1] = o[1] * rstd * n0.y * siluf_(z[1]); r[2] = o[2] * rstd * n0.z * siluf_(z[2]); r[3] = o[3] * rstd * n0.w * siluf_(z[3]);
            r[4] = o[4] * rstd * n1.x * siluf_(z[4]); r[5] = o[5] * rstd * n1.y * siluf_(z[5]); r[6] = o[6] * rstd * n1.z * siluf_(z[6]); r[7] = o[7] * rstd * n1.w * siluf_(z[7]);
            *(v4u*)(C.O + (size_t)m * DM + c0) = pack8(r);
        }
    }
}

template <int PASS>
__device__ __forceinline__ void lru_item(const Ctx& C, int jl, int item, LAS unsigned char* lds) {
    const int tid = otid(), lane = tid & 63, w = tid >> 6, l15 = lane & 15, quad = lane >> 4;
    const bool sample = item >= 2048;
    const int it2 = sample ? item - 2048 : item;
    const int n = it2 & 15;
    const int chunk = sample ? 0 : (PASS == 3 ? (it2 >> 6) : ((it2 >> 4) & 31)), b = sample ? 0 : (PASS == 3 ? ((it2 >> 4) & 3) : (it2 >> 9)), bg = sample ? (it2 >> 4) : 0;
    const size_t tok0 = sample ? (size_t)NPT + bg * 64 : (size_t)b * TP + chunk * 64;
    LAS float* sXC = (LAS float*)lds;
    LAS float* sAa = sXC + 64 * 132;
    LAS float* sBb = sAa + 64 * 132;
    LAS float* sSegP = sBb + 64 * 132;
    LAS float* sSegH = sSegP + 1024;
    LAS float* sCarry = sSegH + 1024;
    LAS bf16* sXB = (LAS bf16*)(sCarry + 128);
    LAS float* sCP = (LAS float*)(sXB + 64 * 136);
    LAS float* sCH = sCP + 512;
    const bf16* proj = C.PROJ;
    const float* cw = C.in[19] + (size_t)jl * 4 * 2048;
    const int col = tid & 127, sg0 = tid >> 7;
    const int d = w * 16 + l15, chd = n * 128 + d;
    bf16x8 bA[4], bX[4];
#pragma unroll
    for (int kk = 0; kk < 4; ++kk) {
        bA[kk] = *(const bf16x8*)(C.WLA + (size_t)(jl * 16 + n) * 16384 + ((w * 4 + kk) * 64 + lane) * 8);
        bX[kk] = *(const bf16x8*)(C.WLX + (size_t)(jl * 16 + n) * 16384 + ((w * 4 + kk) * 64 + lane) * 8);
    }
    const float ba = C.in[22][jl * 2048 + chd], bx_ = C.in[24][jl * 2048 + chd], lam = C.in[25][jl * 2048 + chd];
    unsigned short gt[16]; float h0[2] = {0.f, 0.f};
    if (PASS >= 2) {
#pragma unroll
        for (int q = 0; q < 2; ++q) {
            const int sgm = sg0 + 4 * q;
#pragma unroll
            for (int r8 = 0; r8 < 8; ++r8) gt[q * 8 + r8] = proj[(tok0 + sgm * 8 + r8) * 4096 + 2048 + n * 128 + col];
            if (sample) h0[q] = C.in[5][(size_t)(jl * 128 + bg * 8 + sgm) * 2048 + n * 128 + col];
        }
    }
    float cP = 1.f, cH = 0.f;
    if (PASS == 2 && !sample) {
        float2 ph[8];
#pragma unroll
        for (int i = 0; i < 8; ++i) { const int cc = sg0 * 8 + i; ph[i] = (cc < chunk) ? *(const float2*)(C.SUM + ((size_t)(b * 32 + cc) * 2048 + n * 128 + col) * 2) : make_float2(1.f, 0.f); }
#pragma unroll
        for (int i = 0; i < 8; ++i) { cH = ph[i].x * cH + ph[i].y; cP *= ph[i].x; }
    }
    v4u xr[2][4];
#pragma unroll
    for (int u = 0; u < 2; ++u) {
        const int idx = tid + u * 512, r = idx >> 4, c8 = (idx & 15) * 8, chn = n * 128 + c8;
#pragma unroll
        for (int j = 0; j < 4; ++j) {
            xr[u][j] = (v4u){0u, 0u, 0u, 0u};
            if (!sample) { const int t = chunk * 64 + r - 3 + j; if (t >= 0) xr[u][j] = *(const v4u*)(proj + ((size_t)b * TP + t) * 4096 + chn); }
            else { const int bb = r >> 3, tl = (r & 7) - 3 + j;
                if (tl >= 0) xr[u][j] = *(const v4u*)(proj + ((size_t)NPT + (bg * 8 + bb) * 8 + tl) * 4096 + chn); }
        }
    }
#pragma unroll
    for (int u = 0; u < 2; ++u) {
        const int idx = tid + u * 512, r = idx >> 4, c8 = (idx & 15) * 8, chn = n * 128 + c8;
        float acc[8];
        { const f32x4 b0 = *(const f32x4*)(C.in[20] + jl * 2048 + chn), b1 = *(const f32x4*)(C.in[20] + jl * 2048 + chn + 4);
          acc[0] = b0.x; acc[1] = b0.y; acc[2] = b0.z; acc[3] = b0.w; acc[4] = b1.x; acc[5] = b1.y; acc[6] = b1.z; acc[7] = b1.w; }
#pragma unroll
        for (int j = 0; j < 4; ++j) {
            float x[8]; unpack8(xr[u][j], x);
            if (sample && j < 3) { const int tl = (r & 7) - 3 + j;
                if (tl < 0) { const float* sp = C.in[6] + ((size_t)(jl * 128 + bg * 8 + (r >> 3)) * 3 + (3 + tl)) * 2048 + chn; const f32x4 h0v = *(const f32x4*)sp, h1v = *(const f32x4*)(sp + 4);
                    x[0] = h0v.x; x[1] = h0v.y; x[2] = h0v.z; x[3] = h0v.w; x[4] = h1v.x; x[5] = h1v.y; x[6] = h1v.z; x[7] = h1v.w; } }
            const f32x4 w0 = *(const f32x4*)(cw + j * 2048 + chn), w1 = *(const f32x4*)(cw + j * 2048 + chn + 4);
            acc[0] += x[0] * w0.x; acc[1] += x[1] * w0.y; acc[2] += x[2] * w0.z; acc[3] += x[3] * w0.w;
            acc[4] += x[4] * w1.x; acc[5] += x[5] * w1.y; acc[6] += x[6] * w1.z; acc[7] += x[7] * w1.w;
            if (PASS >= 2 && j == 3) {
                float* o = nullptr;
                if (!sample) { if (chunk == 31 && r >= 61) o = C.out + O_PLCONV + ((size_t)(jl * 4 + b) * 3 + (r - 61)) * 2048 + chn; }
                else { if ((r & 7) >= 5) o = C.out + O_SLCONV + ((size_t)(jl * 128 + bg * 8 + (r >> 3)) * 3 + ((r & 7) - 5)) * 2048 + chn; }
                if (o) { *(f32x4*)o = (f32x4){x[0], x[1], x[2], x[3]}; *(f32x4*)(o + 4) = (f32x4){x[4], x[5], x[6], x[7]}; }
            }
        }
        *(LAS f32x4*)(sXC + r * 132 + c8) = (f32x4){acc[0], acc[1], acc[2], acc[3]};
        *(LAS f32x4*)(sXC + r * 132 + c8 + 4) = (f32x4){acc[4], acc[5], acc[6], acc[7]};
        *(LAS v4u*)(sXB + r * 136 + c8) = pack8(acc);
    }
    if (PASS == 2 && !sample) { sCP[sg0 * 128 + col] = cP; sCH[sg0 * 128 + col] = cH; }
    __syncthreads();
    if (PASS == 2 && !sample && tid < 128) {
        float hc = 0.f;
#pragma unroll
        for (int q = 0; q < 4; ++q) hc = sCP[q * 128 + tid] * hc + sCH[q * 128 + tid];
        sCarry[tid] = hc;
    }
    {
        f32x4 accA[4], accX[4];
#pragma unroll
        for (int m = 0; m < 4; ++m) { accA[m] = (f32x4){0.f, 0.f, 0.f, 0.f}; accX[m] = accA[m]; }
#pragma unroll
        for (int kk = 0; kk < 4; ++kk) {
#pragma unroll
            for (int m = 0; m < 4; ++m) {
                const bf16x8 a = *(const LAS bf16x8*)(sXB + (m * 16 + l15) * 136 + kk * 32 + quad * 8);
                accA[m] = __builtin_amdgcn_mfma_f32_16x16x32_bf16(a, bA[kk], accA[m], 0, 0, 0);
                accX[m] = __builtin_amdgcn_mfma_f32_16x16x32_bf16(a, bX[kk], accX[m], 0, 0, 0);
            }
        }
        const float c2 = -8.0f * 1.4426950408889634f * softplusf_(-lam);
#pragma unroll
        for (int m = 0; m < 4; ++m)
#pragma unroll
            for (int j = 0; j < 4; ++j) {
                const int row = m * 16 + quad * 4 + j;
                const float rg = sigmoidf_(accA[m][j] + ba), ig = sigmoidf_(accX[m][j] + bx_);
                const float a = __builtin_amdgcn_exp2f(c2 * rg);
                float mult = __builtin_amdgcn_sqrtf(fmaxf(1.0f - a * a, 0.f));
                if (!sample && chunk == 0 && row == 0) mult = 1.0f;
                sAa[row * 132 + d] = a; sBb[row * 132 + d] = mult * ig * sXC[row * 132 + d];
            }
    }
    __syncthreads();
#pragma unroll
    for (int q = 0; q < 2; ++q) {
        const int sgm = sg0 + 4 * q;
        float P = 1.f, hh = 0.f;
#pragma unroll
        for (int r8 = 0; r8 < 8; ++r8) { const int row = sgm * 8 + r8; const float a = sAa[row * 132 + col]; hh = a * hh + sBb[row * 132 + col]; P *= a; }
        sSegP[sgm * 128 + col] = P; sSegH[sgm * 128 + col] = hh;
    }
    __syncthreads();
    if (PASS == 3) {
        if (!sample && tid < 128) {
            float P = 1.f, hh = 0.f;
#pragma unroll
            for (int s = 0; s < 8; ++s) { const float ps = sSegP[s * 128 + tid]; hh = ps * hh + sSegH[s * 128 + tid]; P *= ps; }
            unsigned long long* gr = C.CARRY + ((size_t)((jl * 4 + b) * 32 + chunk) * 2048 + n * 128 + tid);
            float cin = 0.f;
            if (chunk > 0) {
                unsigned long long g = 0ull; unsigned spins = 0;
                for (;;) { g = __hip_atomic_load(gr - 2048, __ATOMIC_RELAXED, __HIP_MEMORY_SCOPE_AGENT); if ((unsigned)(g >> 32) == 1u || ++spins > (1u << 20)) break; __builtin_amdgcn_s_sleep(1); }
                cin = __uint_as_float((unsigned)g);
            }
            const float cout = P * cin + hh;
            __hip_atomic_store(gr, (1ull << 32) | (unsigned long long)__float_as_uint(cout), __ATOMIC_RELAXED, __HIP_MEMORY_SCOPE_AGENT);
            sCarry[tid] = cin;
        }
        __syncthreads();
    }
    if (PASS == 1) {
        if (tid < 128) {
            float P = 1.f, hh = 0.f;
#pragma unroll
            for (int s = 0; s < 8; ++s) { const float ps = sSegP[s * 128 + tid]; hh = ps * hh + sSegH[s * 128 + tid]; P *= ps; }
            *(float2*)(C.SUM + ((size_t)(b * 32 + chunk) * 2048 + n * 128 + tid) * 2) = make_float2(P, hh);
        }
    } else {
#pragma unroll
        for (int q = 0; q < 2; ++q) {
            const int sgm = sg0 + 4 * q;
            float hh;
            if (sample) hh = h0[q];
            else { hh = sCarry[col]; for (int s = 0; s < sgm; ++s) hh = sSegP[s * 128 + col] * hh + sSegH[s * 128 + col]; }
#pragma unroll
            for (int r8 = 0; r8 < 8; ++r8) {
                const int row = sgm * 8 + r8;
                hh = sAa[row * 132 + col] * hh + sBb[row * 132 + col];
                const float gate = bf2f(gt[q * 8 + r8]);
                C.O[(tok0 + row) * DM + n * 128 + col] = (bf16)f2bf(hh * siluf_(gate));
            }
            if (sample) C.out[O_SLRU + (size_t)(jl * 128 + bg * 8 + sgm) * 2048 + n * 128 + col] = hh;
            else if (chunk == 31 && sgm == 7) C.out[O_PLRU + (size_t)(jl * 4 + b) * 2048 + n * 128 + col] = hh;
        }
    }
    __syncthreads();
}

#define XB_TMO      128
#define XB_XCNT(j)  (256  + 64 * (j))
#define XB_XSUB(j)  (1280 + 64 * (j))
#define XB_XGEN(j)  (2304 + 64 * (j))
#define XB_TOP      3328
#define XB_TOPGEN   3392
#define XCD_BAR_WORDS 3456
#define XB_SPIN_CAP (1u << 18)

__device__ __forceinline__ unsigned xb_ld(unsigned* p)              { return __hip_atomic_load(p, __ATOMIC_RELAXED, __HIP_MEMORY_SCOPE_AGENT); }
__device__ __forceinline__ unsigned xb_add(unsigned* p, unsigned v) { return __hip_atomic_fetch_add(p, v, __ATOMIC_RELAXED, __HIP_MEMORY_SCOPE_AGENT); }
__device__ __forceinline__ unsigned xb_xcc_id() { return (unsigned)__builtin_amdgcn_s_getreg((3 << 11) | 20) & 0xFu; }
#define XB_SPIN(cond, bar) do { unsigned _sp = 0; while (cond) { __builtin_amdgcn_s_sleep(1); \
    if ((++_sp & 255u) == 0u) { if (xb_ld(&(bar)[XB_TMO])) break; if (_sp > XB_SPIN_CAP) { atomicAdd(&(bar)[XB_TMO], 1u); break; } } } } while (0)

struct XcdBarrier {
    unsigned* bar; unsigned x;
    volatile LAS unsigned* st;
};

__device__ __forceinline__ XcdBarrier xcd_barrier_post(unsigned* bar, volatile LAS unsigned* st) {
    XcdBarrier b; b.bar = bar; b.x = xb_xcc_id(); b.st = st;
    if (threadIdx.x == 0) (void)xb_add(&bar[XB_XCNT(b.x)], 1u);
    return b;
}
__device__ __forceinline__ void xcd_barrier_complete(unsigned* bar, unsigned x, unsigned& nloc, unsigned& nx) {
    const unsigned G = gridDim.x * gridDim.y * gridDim.z;
    unsigned sum, cnt, mine, sp = 0u;
    for (;;) {
        sum = 0u; cnt = 0u; mine = 0u;
#pragma unroll
        for (unsigned j = 0; j < 16; ++j) { const unsigned c = xb_ld(&bar[XB_XCNT(j)]); sum += c; cnt += (c > 0u) ? 1u : 0u; mine = (j == x) ? c : mine; }
        if (sum == G) break;
        __builtin_amdgcn_s_sleep(1);
        if ((++sp & 255u) == 0u) { if (xb_ld(&bar[XB_TMO])) break; if (sp > XB_SPIN_CAP) { atomicAdd(&bar[XB_TMO], 1u); break; } }
    }
    nloc = mine > 0u ? mine : 1u; nx = cnt > 0u ? cnt : 1u;
}

__device__ __forceinline__ void xcd_barrier(const XcdBarrier& b) {
    asm volatile("s_waitcnt vmcnt(0)" ::: "memory");
    __syncthreads();
    if (threadIdx.x == 0) {
        unsigned* bar = b.bar;
        __builtin_amdgcn_s_waitcnt(0);
        unsigned nloc = b.st[0], nx = b.st[1];
        if (nloc == 0u) { xcd_barrier_complete(bar, b.x, nloc, nx); b.st[0] = nloc; b.st[1] = nx; }
        const unsigned old = xb_add(&bar[XB_XSUB(b.x)], 1u);
        const unsigned gen = old / nloc;
        if (old + 1u == (gen + 1u) * nloc) {
            __builtin_amdgcn_fence(__ATOMIC_RELEASE, "agent");
            asm volatile("s_waitcnt vmcnt(0)" ::: "memory");
            const unsigned og = xb_add(&bar[XB_TOP], 1u);
            const unsigned tg = og / nx;
            if (og + 1u == (tg + 1u) * nx) xb_add(&bar[XB_TOPGEN], 1u);
            else XB_SPIN(xb_ld(&bar[XB_TOPGEN]) == tg, bar);
            __builtin_amdgcn_fence(__ATOMIC_ACQUIRE, "agent");
            xb_add(&bar[XB_XGEN(b.x)], 1u);
            asm volatile("s_waitcnt vmcnt(0)" ::: "memory");
        } else {
            XB_SPIN(xb_ld(&bar[XB_XGEN(b.x)]) == gen, bar);
            __builtin_amdgcn_fence(__ATOMIC_ACQUIRE, "agent");
            asm volatile("s_waitcnt vmcnt(0)" ::: "memory");
        }
    }
    __syncthreads();
}

struct OneUnit {
    int pm, pn;
    __device__ bool next(int i, pg8::Unit& u) const { if (i != 0) return false; u.pm = pm; u.pn = pn; return true; }
    __device__ __forceinline__ void a_ready(const pg8::Unit&) const {}
    __device__ __forceinline__ void done(const pg8::Unit&) const {}
};
constexpr int TAB_OFF = 143360;
__device__ __forceinline__ unsigned long long tab_ld(LAS unsigned char* lds, int i) {
    const volatile LAS unsigned* t = (const volatile LAS unsigned*)(lds + TAB_OFF) + 2 * i;
    const unsigned lo = __builtin_amdgcn_readfirstlane(t[0]), hi = __builtin_amdgcn_readfirstlane(t[1]);
    return ((unsigned long long)hi << 32) | lo;
}
__device__ __forceinline__ Ctx make_ctx(LAS unsigned char* lds) {
    Ctx C;
#pragma unroll
    for (int i = 0; i < 28; ++i) C.in[i] = (const float*)tab_ld(lds, i);
    C.out = (float*)tab_ld(lds, 28);
    unsigned char* ws = (unsigned char*)tab_ld(lds, 29);
    C.G = gridDim.x;
    C.WABIN = (bf16*)(ws + WS_WABIN); C.WABOUT = (bf16*)(ws + WS_WABOUT); C.WLIN = (bf16*)(ws + WS_WLIN); C.WLOUT = (bf16*)(ws + WS_WLOUT);
    C.WLA = (bf16*)(ws + WS_WLA); C.WLX = (bf16*)(ws + WS_WLX);
    C.X = (float*)(ws + WS_X); C.H = (bf16*)(ws + WS_H); C.O = (bf16*)(ws + WS_O); C.PROJ = (bf16*)(ws + WS_PROJ);
    C.G_W = (bf16*)(ws + WS_GW); C.G_QG = (bf16*)(ws + WS_GQG); C.G_KDT = (bf16*)(ws + WS_GKDT); C.G_QK = (bf16*)(ws + WS_GQK); C.G_UT = (float*)(ws + WS_GUT);
    C.L_QG = (bf16*)(ws + WS_LQG); C.L_KDT = (bf16*)(ws + WS_LKDT); C.L_A = (bf16*)(ws + WS_LA); C.L_VT = (bf16*)(ws + WS_LVT);
    C.G_DEC = (float*)(ws + WS_GDEC); C.L_DEC = (float*)(ws + WS_LDEC); C.SUM = (float*)(ws + WS_SUM); C.SS = (float*)(ws + 65536); C.CARRY = (unsigned long long*)(ws + WS_CARRY);
    return C;
}
#ifndef TYPE_MASK
#define TYPE_MASK 0xFFFF
#endif
#define TY(t) ((TYPE_MASK >> (t)) & 1)
#ifndef REP_MASK
#define REP_MASK 0
#endif
#define REP(t) for (int rep_ = 0; rep_ < (((REP_MASK >> (t)) & 1) ? 2 : 1); ++rep_)
__global__ void __launch_bounds__(512, 2) mk_fwd(Params p) {
    extern __shared__ __attribute__((aligned(16))) unsigned char lds_raw[];
    LAS unsigned char* lds = (LAS unsigned char*)lds_raw;
    if (threadIdx.x == 0) {
        LAS unsigned long long* t = (LAS unsigned long long*)(lds + TAB_OFF);
#pragma unroll
        for (int i = 0; i < 28; ++i) t[i] = (unsigned long long)p.in[i];
        t[28] = (unsigned long long)p.out; t[29] = (unsigned long long)p.ws;
    }
    if (threadIdx.x < 2) ((LAS unsigned*)(lds + TAB_OFF + 256))[threadIdx.x] = 0u;
    __syncthreads();
    const int lo = p.ph_lo, hi = p.ph_hi;
    const int G = gridDim.x;
    cg::grid_group grid = cg::this_grid();
    XcdBarrier xbar; xbar.bar = (unsigned*)p.ws; xbar.x = 0; xbar.st = nullptr;
    if (hi - lo > 1) xbar = xcd_barrier_post((unsigned*)p.ws, (volatile LAS unsigned*)(lds + TAB_OFF + 256));
#define IN(k) (lo <= (k) && (k) < hi)
#define SEAM2(k, kn) do { if (IN(k) && IN(kn)) { xcd_barrier(xbar); } } while (0)
    if (hi < 0) grid.sync();
#define SEAM(k) do { if (IN(k) && IN((k) + 1)) { xcd_barrier(xbar); } } while (0)
#define GW_DECL const int tid_ = otid(), bid = obid(), lane = tid_ & 63, gw = bid * 8 + (tid_ >> 6), NGW = G * 8

    REP(0) if (TY(0) && IN(0)) { const Ctx C = make_ctx(lds); prologue_phase(C, lds); }
    SEAM(0);
#pragma unroll 1
    for (int l = 0; l < 4; ++l) {
        const int j = l >> 1;
        if ((l & 1) == 0) {
            const int P0 = (l == 0) ? 1 : 12;
            REP(1) if (TY(1) && IN(P0)) {
                const Ctx C = make_ctx(lds); const int bid = obid();
                pg8::Gemm g{C.H, C.WABIN + (size_t)j * ABNP * 2048, NTOK, ABNP, DM}; pg8::StaticOrder S; S.init(NTOK, ABNP, G, bid);
                pg8::EpiProj E{C.PROJ, ABNP, (l == 0) ? (const float*)nullptr : C.SS + (size_t)(l - 1) * NTOK};
                pg8::gemm_phase<pg8::EpiProj, pg8::StaticOrder, true, true>(lds, g, S, E);
                if (l == 0 && G == 256) convert_segment(C, lds, 1, 20);
            }
            SEAM(P0);
            REP(2) if (TY(2) && IN(P0 + 1)) {
                const Ctx C = make_ctx(lds); const int bid = obid();
                for (int it = bid; it < 1536; it += G) { if (it < 1024) gdn_prep_item(C, j, it, lds); else gla_prep_item(C, j, it - 1024, lds); }
            }
            SEAM(P0 + 1);
            REP(3) if (TY(3) && IN(P0 + 2)) {
                const Ctx C = make_ctx(lds); const int bid = obid();
                REP(13) if (G == 256) {
                    const int xcd = bid & 7, slot = bid >> 3;
                    if (slot < 16) scan_task<true>(C, j, (xcd * 4 + (slot >> 2)) * 4 + (slot & 3), lds);
                    else scan_task<false>(C, j, (xcd * 2 + ((slot - 16) >> 3)) * 8 + ((slot - 16) & 7), lds);
                } else
                for (int t = bid; t < 256; t += G) { if (t < 128) scan_task<true>(C, j, t, lds); else scan_task<false>(C, j, t - 128, lds); }
                for (int it = bid; it < 1536; it += G) { if (it < 1024) gdn_sample_item(C, j, it, lds); else gla_sample_item(C, j, it - 1024, lds); }
            }
            SEAM(P0 + 2);
            REP(4) if (TY(4) && IN(P0 + 3)) {
                const Ctx C = make_ctx(lds);
                if (G == 256) {
                    const int bid = obid();
                    if (bid < 32) {
                        const float* resS = (l == 0) ? C.in[1] : C.X + (size_t)NPT * DM;
                        pg8::Gemm g{C.O, C.WABOUT + (size_t)j * 2048 * 2048, NTOK, DM, DM}; OneUnit S1{32 + (bid >> 3), bid & 7};
                        pg8::EpiRes E{C.X, resS, C.X, DM, C.H, C.in[17] + j * DM, C.SS + (size_t)l * NTOK};
                        pg8::gemm_phase<pg8::EpiRes, OneUnit, true, true>(lds, g, S1, E);
                    } else {
                        const int tid_ = otid(), lane = tid_ & 63;
                        gatenorm_phase(C, j, (bid - 32) * 8 + (tid_ >> 6), 224 * 8, lane);
                        if (l == 0) convert_segment(C, lds, 2, 32);
                    }
                } else { GW_DECL; gatenorm_phase(C, j, gw, NGW, lane); }
            }
            SEAM(P0 + 3);
            REP(5) if (TY(5) && IN(P0 + 4)) {
                const Ctx C = make_ctx(lds); const int bid = obid();
                const float* resP = (l == 0) ? C.in[0] : C.X;
                const float* resS = (l == 0) ? C.in[1] : C.X + (size_t)NPT * DM;
                pg8::Gemm g{C.O, C.WABOUT + (size_t)j * 2048 * 2048, NTOK, DM, DM}; pg8::StaticOrder S; S.init((G == 256) ? NPT : NTOK, DM, G, bid);
                pg8::EpiRes E{resP, resS, C.X, DM, C.H, C.in[17] + j * DM, C.SS + (size_t)l * NTOK};
                pg8::gemm_phase<pg8::EpiRes, pg8::StaticOrder, true, true>(lds, g, S, E);
            }
            SEAM2(P0 + 4, P0 + 6);
        } else {
            const int P0 = (l == 1) ? 7 : 18;
            REP(7) if (TY(7) && IN(P0)) {
                const Ctx C = make_ctx(lds); const int bid = obid();
                pg8::Gemm g{C.H, C.WLIN + (size_t)j * 4096 * 2048, NTOK, 4096, DM}; pg8::StaticOrder S; S.init(NTOK, 4096, G, bid);
                pg8::EpiProj E{C.PROJ, 4096, C.SS + (size_t)(l - 1) * NTOK};
                pg8::gemm_phase<pg8::EpiProj, pg8::StaticOrder, true, true>(lds, g, S, E);
                if (l == 1 && G == 256) convert_segment(C, lds, 3, 64);
            }
            SEAM2(P0, P0 + 2);
            REP(9) if (TY(9) && IN(P0 + 2)) { const Ctx C = make_ctx(lds); const int bid = obid(); for (int it = bid; it < 2304; it += G) lru_item<3>(C, j, it, lds); }
            SEAM(P0 + 2);
            REP(10) if (TY(10) && IN(P0 + 3)) {
                const Ctx C = make_ctx(lds); const int bid = obid();
                pg8::Gemm g{C.O, C.WLOUT + (size_t)j * 2048 * 2048, NTOK, DM, DM}; pg8::StaticOrder S; S.init(NTOK, DM, G, bid);
                pg8::EpiRes E{C.X, C.X + (size_t)NPT * DM, C.X, DM, (l == 1) ? C.H : (bf16*)nullptr, C.in[7] + DM, C.SS + (size_t)l * NTOK};
                pg8::gemm_phase<pg8::EpiRes, pg8::StaticOrder, true, true>(lds, g, S, E);
                if (l == 1 && G == 256) convert_segment(C, lds, 4, 32);
            }
            if (l == 1) SEAM2(P0 + 3, P0 + 5); else SEAM(P0 + 3);
            REP(11) if (TY(11) && IN(P0 + 4)) {
                const Ctx C = make_ctx(lds); GW_DECL;
                if (l == 3) rms_phase_f32(C.X, C.in[27], C.out, gw, NGW, lane);
            }
        }
    }
#undef IN
#undef SEAM
}

extern "C" void kernel_launch(void* const* d_in, const int* in_sizes, int n_in, void* d_out, int out_size, void* d_ws, size_t ws_size, hipStream_t stream) {
    static int grid = 0;
    if (grid == 0) {
        if (n_in != 28 || ws_size < WS_END || (size_t)out_size != O_END) { fprintf(stderr, "kernel_launch: unexpected problem (n_in %d, out %d, ws %zu)\n", n_in, out_size, ws_size); grid = -1; return; }
        int dev = 0, cus = 0, per_cu = 0;
        if (hipGetDevice(&dev) != hipSuccess || hipDeviceGetAttribute(&cus, hipDeviceAttributeMultiprocessorCount, dev) != hipSuccess) { grid = -1; return; }
        if (hipFuncSetAttribute((const void*)mk_fwd, hipFuncAttributeMaxDynamicSharedMemorySize, LDS_BYTES) != hipSuccess) { fprintf(stderr, "kernel_launch: hipFuncSetAttribute failed\n"); grid = -1; return; }
        if (hipOccupancyMaxActiveBlocksPerMultiprocessor(&per_cu, (const void*)mk_fwd, 512, LDS_BYTES) != hipSuccess || per_cu < 1) { fprintf(stderr, "kernel_launch: occupancy query says %d\n", per_cu); per_cu = 1; }
        (void)hipGetLastError();
        grid = cus * per_cu;
    }
    if (grid < 0) return;
    if (hipMemsetAsync(d_ws, 0, 262144, stream) != hipSuccess) { fprintf(stderr, "kernel_launch: memset failed\n"); return; }
    if (hipMemsetAsync((char*)d_ws + WS_CARRY, 0, 4 * MiB, stream) != hipSuccess) { fprintf(stderr, "kernel_launch: memset failed\n"); return; }
    Params p{};
    for (int i = 0; i < 28; ++i) p.in[i] = (const float*)d_in[i];
    p.out = (float*)d_out; p.ws = (unsigned char*)d_ws;
#if ONE_LAUNCH
    p.ph_lo = 0; p.ph_hi = NPHASE;
    void* args[] = {&p};
    hipError_t e = hipLaunchCooperativeKernel((const void*)mk_fwd, dim3(grid), dim3(512), args, LDS_BYTES, stream);
    if (e != hipSuccess) fprintf(stderr, "cooperative launch failed: %s (grid %d)\n", hipGetErrorString(e), grid);
#else
    for (int k = 0; k < NPHASE; ++k) {
        p.ph_lo = k; p.ph_hi = k + 1;
        hipLaunchKernelGGL(mk_fwd, dim3(grid), dim3(512), LDS_BYTES, stream, p);
    }
#endif
}
```

```cpp
#include <hip/hip_runtime.h>
#include <hip/hip_cooperative_groups.h>
#include <cstdio>
#include <cstdint>
namespace cg = cooperative_groups;
namespace pg8 {
#define PG8_LAS __attribute__((address_space(3)))
typedef unsigned short bf16_t;
typedef short bf16x8 __attribute__((ext_vector_type(8)));
typedef float f32x4 __attribute__((ext_vector_type(4)));
typedef unsigned u32x4 __attribute__((ext_vector_type(4)));
constexpr int BM = 256, BK = 64, HALF = 128, HTB = HALF * BK * 2  , STAGE_BYTES = 8 * HTB, NXCD = 8, WGM = 8;

__host__ __device__ __forceinline__ int lds_byte(int r, int c) { const int st = (r >> 4) * 2 + (c >> 5), rr = r & 15, cc = c & 31, ob = rr * 64 + cc * 2; return st * 1024 + (ob ^ (((ob >> 9) & 1) << 5)); }
__host__ __device__ __forceinline__ void stage_rc(int b, int& R, int& C) { const int st = b / 1024, sb = b % 1024, swz = sb ^ (((sb >> 9) & 1) << 5); R = (st >> 1) * 16 + swz / 64; C = (st & 1) * 32 + (swz % 64) / 2; }
__host__ __device__ __forceinline__ int perm32(int rho) { const int n = rho >> 4, i = rho & 15; return 8 * (i >> 2) + 4 * n + (i & 3); }

struct Unit { int pm, pn; };
struct Gemm { const bf16_t* A; const bf16_t* Bt; int M, N, K; };

struct StaticOrder {
    int nM, nN, nwg, G, c;
    __host__ __device__ void init(int M, int N, int G_, int c_) { nM = M / BM; nN = N / BM; nwg = nM * nN; G = G_; c = c_; }
    __host__ __device__ bool next(int i, Unit& u) const {
        const long L = (long)i * G + c; if (L >= nwg) return false;
        int wgid = (int)L; { const int q = nwg / NXCD, r = nwg % NXCD, xcd = wgid % NXCD, off = wgid / NXCD; wgid = (xcd < r ? xcd * (q + 1) : r * (q + 1) + (xcd - r) * q) + off; }
        const int nig = WGM * nN, gid = wgid / nig, fm = gid * WGM, gsz = (nM - fm) < WGM ? (nM - fm) : WGM;
        u.pm = fm + ((wgid % nig) % gsz); u.pn = (wgid % nig) / gsz; return true;
    }
    __device__ __forceinline__ void a_ready(const Unit&) const {}
    __device__ __forceinline__ void done(const Unit&) const {}
};

__device__ __forceinline__ unsigned cvt_pk_bf16(float lo, float hi) { unsigned r; asm volatile("v_cvt_pk_bf16_f32 %0, %1, %2" : "=v"(r) : "v"(lo), "v"(hi)); return r; }
typedef float f32x2 __attribute__((ext_vector_type(2)));
struct EpiProj {
    static constexpr bool PERM = true, AFTER_DRAIN = false;
    bf16_t* O; int ldc; const float* ss;
    __device__ __forceinline__ void operator()(const f32x4 (&acc)[2][2][4][2], const Unit& u, int wr, int wc, int fr, int fq) const {
        const int row0 = u.pm * BM + wr * 64 + fr, col0 = u.pn * BM + wc * 32 + 8 * fq;
#pragma unroll
        for (int ai = 0; ai < 2; ++ai)
#pragma unroll
            for (int m = 0; m < 4; ++m) { bf16_t* rowp = O + (size_t)(row0 + ai * HALF + m * 16) * ldc + col0;
                const float rs = ss ? rsqrtf(ss[row0 + ai * HALF + m * 16] * (1.0f / 2048.0f) + 1e-6f) : 1.0f;
#pragma unroll
                for (int bj = 0; bj < 2; ++bj) { const f32x4 v0 = acc[ai][bj][m][0] * rs, v1 = acc[ai][bj][m][1] * rs;
                    u32x4 w; w.x = cvt_pk_bf16(v0[0], v0[1]); w.y = cvt_pk_bf16(v0[2], v0[3]); w.z = cvt_pk_bf16(v1[0], v1[1]); w.w = cvt_pk_bf16(v1[2], v1[3]);
                    *(u32x4*)(rowp + bj * HALF) = w; } }
    }
};
struct EpiRes {
    static constexpr bool PERM = false, AFTER_DRAIN = false;
    const float* baseP; const float* baseS; float* out; int ldc;
    bf16_t* Hn; const float* gn; float* ss;
    __device__ __forceinline__ void operator()(const f32x4 (&acc)[2][2][4][2], const Unit& u, int wr, int wc, int fr, int fq) const {
        const int row0 = u.pm * BM + wr * 64 + fr, col0 = u.pn * BM + wc * 32 + 4 * fq;
        f32x4 g4[2][2];
        if (Hn) {
#pragma unroll
            for (int bj = 0; bj < 2; ++bj)
#pragma unroll
                for (int n = 0; n < 2; ++n) g4[bj][n] = *(const f32x4*)(gn + col0 + bj * HALF + n * 16);
        }
#pragma unroll
        for (int ai = 0; ai < 2; ++ai)
#pragma unroll
            for (int m = 0; m < 4; ++m) { const int row = row0 + ai * HALF + m * 16;
                const float* bp = (row < 8192 ? baseP + (size_t)row * ldc : baseS + (size_t)(row - 8192) * ldc) + col0;
                float* op = out + (size_t)row * ldc + col0;
                float part = 0.f;
#pragma unroll
                for (int bj = 0; bj < 2; ++bj)
#pragma unroll
                    for (int n = 0; n < 2; ++n) { const f32x4 v = *(const f32x4*)(bp + bj * HALF + n * 16) + acc[ai][bj][m][n];
                        *(f32x4*)(op + bj * HALF + n * 16) = v;
                        if (Hn) { part += (v[0] * v[0] + v[1] * v[1]) + (v[2] * v[2] + v[3] * v[3]); const f32x4 gg = g4[bj][n];
                            unsigned w0 = cvt_pk_bf16(v[0] * gg[0], v[1] * gg[1]), w1 = cvt_pk_bf16(v[2] * gg[2], v[3] * gg[3]);
                            typedef unsigned u32x2 __attribute__((ext_vector_type(2)));
                            *(u32x2*)(Hn + (size_t)row * ldc + col0 + bj * HALF + n * 16) = (u32x2){w0, w1}; } }
                if (Hn) { part += __shfl_xor(part, 16); part += __shfl_xor(part, 32); if (fq == 0) unsafeAtomicAdd(ss + row, part); } }
    }
};
template <class Epi, class Sched, bool ALIGN_EPI = false, bool SP2 = false>
__device__ __forceinline__ void gemm_phase(PG8_LAS unsigned char* lds, const Gemm g, const Sched& S, const Epi& E) {
    int tid = threadIdx.x; asm volatile("" : "+v"(tid)); const int wid = __builtin_amdgcn_readfirstlane(tid >> 6), lane = tid & 63, wr = wid >> 2, wc = wid & 3, fr = lane & 15, fq = lane >> 4;
    const int K = g.K, nt = K / BK;
    unsigned voffA[2], voffB[2];
#pragma unroll
    for (int i = 0; i < 2; ++i) { int R, C; stage_rc(tid * 16 + i * 8192, R, C); const int Rb = Epi::PERM ? ((R & ~31) + perm32(R & 31)) : R;
        voffA[i] = (unsigned)(R * K + C) * 2u; voffB[i] = (unsigned)(Rb * K + C) * 2u; }
    const size_t kstep = (size_t)(BK * 2);
    const size_t hstep = (size_t)HALF * K * 2;
    const size_t tstep = 2 * hstep;
    const unsigned ldsw = (unsigned)wid * 1024u;
    const int aoff = lds_byte(wr * 64 + fr, fq * 8), boff = lds_byte(wc * 32 + fr, fq * 8);
#define PG8_SA(b, h) (((b) * 2 + (h)) * HTB)
#define PG8_SB(b, h) ((4 + (b) * 2 + (h)) * HTB)
#define PG8_STAGE(bufoff, gbase, voff) do { _Pragma("unroll") for (int _i = 0; _i < 2; ++_i) \
        __builtin_amdgcn_global_load_lds((const unsigned*)((const char*)(gbase) + (voff)[_i]), (PG8_LAS unsigned*)(lds + (bufoff) + ldsw + _i * 8192), 16, 0, 0); } while (0)
#define PG8_LDA(dst, b, h) do { _Pragma("unroll") for (int m = 0; m < 4; ++m) _Pragma("unroll") for (int k = 0; k < 2; ++k) dst[m][k] = *(const PG8_LAS bf16x8*)(lds + PG8_SA(b, h) + aoff + m * 2048 + k * 1024); } while (0)
#define PG8_LDB(dst, b, h) do { _Pragma("unroll") for (int n = 0; n < 2; ++n) _Pragma("unroll") for (int k = 0; k < 2; ++k) dst[n][k] = *(const PG8_LAS bf16x8*)(lds + PG8_SB(b, h) + boff + n * 2048 + k * 1024); } while (0)
#define PG8_MMA(ai, bj, At, Bt) do { __builtin_amdgcn_s_setprio(1); _Pragma("unroll") for (int m = 0; m < 4; ++m) _Pragma("unroll") for (int n = 0; n < 2; ++n) _Pragma("unroll") for (int k = 0; k < 2; ++k) \
        acc[ai][bj][m][n] = __builtin_amdgcn_mfma_f32_16x16x32_bf16(Bt[n][k], At[m][k], acc[ai][bj][m][n], 0, 0, 0); __builtin_amdgcn_s_setprio(0); } while (0)
#define PG8_WAIT_V(n) asm volatile("s_waitcnt vmcnt(" #n ")" ::: "memory")
#define PG8_WAIT_L(n) asm volatile("s_waitcnt lgkmcnt(" #n ")" ::: "memory")
#define PG8_BAR __builtin_amdgcn_s_barrier()
#define PG8_SCHED __builtin_amdgcn_sched_barrier(0)
    Unit cur, nxt; int ui = 0;
    if (!S.next(0, cur)) return;
    f32x4 acc[2][2][4][2];
#pragma unroll
    for (int a = 0; a < 2; ++a)
#pragma unroll
        for (int b = 0; b < 2; ++b)
#pragma unroll
            for (int m = 0; m < 4; ++m)
#pragma unroll
                for (int n = 0; n < 2; ++n) acc[a][b][m][n] = (f32x4){0.f, 0.f, 0.f, 0.f};
    bf16x8 At[4][2], B0[2][2], B1[2][2];
    const char* cA = (const char*)g.A + (size_t)cur.pm * tstep; const char* cB = (const char*)g.Bt + (size_t)cur.pn * tstep;
    S.a_ready(cur);
    if constexpr (SP2) {
        PG8_STAGE(PG8_SB(0, 0), cB, voffB); PG8_STAGE(PG8_SB(0, 1), cB + hstep, voffB); PG8_STAGE(PG8_SA(0, 0), cA, voffA); PG8_STAGE(PG8_SA(0, 1), cA + hstep, voffA);
        if (wr == 1) PG8_BAR;
        PG8_WAIT_V(2); PG8_BAR;
        PG8_STAGE(PG8_SB(1, 0), cB + kstep, voffB); PG8_STAGE(PG8_SA(1, 0), cA + kstep, voffA); PG8_STAGE(PG8_SB(1, 1), cB + hstep + kstep, voffB);
        PG8_WAIT_V(6); PG8_BAR;
    } else {
        PG8_STAGE(PG8_SB(0, 0), cB, voffB); PG8_STAGE(PG8_SA(0, 0), cA, voffA); PG8_STAGE(PG8_SB(0, 1), cB + hstep, voffB); PG8_STAGE(PG8_SA(0, 1), cA + hstep, voffA);
        if (wr == 1) PG8_BAR;
        PG8_WAIT_V(4); PG8_BAR;
        PG8_STAGE(PG8_SB(1, 0), cB + kstep, voffB); PG8_STAGE(PG8_SA(1, 0), cA + kstep, voffA); PG8_STAGE(PG8_SB(1, 1), cB + hstep + kstep, voffB);
        PG8_WAIT_V(6); PG8_BAR;
    }
    for (;;) {
        const bool has_next = S.next(ui + 1, nxt);
        const char* nA = has_next ? (const char*)g.A + (size_t)nxt.pm * tstep : cA; const char* nB = has_next ? (const char*)g.Bt + (size_t)nxt.pn * tstep : cB;
        for (int t = 0; t < nt; t += 2) {
            const bool last = (t == nt - 2);
            const char* a1 = cA + (size_t)(t + 1) * kstep;
            const char* a2 = last ? nA : cA + (size_t)(t + 2) * kstep; const char* b2 = last ? nB : cB + (size_t)(t + 2) * kstep;
            const char* a3 = a2 + kstep; const char* b3 = b2 + kstep;
            if (last && has_next) S.a_ready(nxt);
            if constexpr (SP2) {
            PG8_LDB(B0, 0, 0); PG8_LDB(B1, 0, 1); PG8_SCHED; PG8_LDA(At, 0, 0); PG8_STAGE(PG8_SA(1, 1), a1 + hstep, voffA);
            PG8_WAIT_V(8); PG8_WAIT_L(0); PG8_BAR; PG8_MMA(0, 0, At, B0); PG8_MMA(0, 1, At, B1); PG8_BAR; PG8_SCHED;
            PG8_LDA(At, 0, 1); PG8_STAGE(PG8_SB(0, 0), b2, voffB); PG8_STAGE(PG8_SB(0, 1), b2 + hstep, voffB); PG8_STAGE(PG8_SA(0, 0), a2, voffA);
            PG8_WAIT_V(8); PG8_WAIT_L(0); PG8_BAR; PG8_MMA(1, 0, At, B0); PG8_MMA(1, 1, At, B1); PG8_BAR; PG8_SCHED;
            PG8_LDB(B0, 1, 0); PG8_LDB(B1, 1, 1); PG8_SCHED; PG8_LDA(At, 1, 0); PG8_STAGE(PG8_SA(0, 1), a2 + hstep, voffA);
            PG8_WAIT_V(8); PG8_WAIT_L(0); PG8_BAR; PG8_MMA(0, 0, At, B0); PG8_MMA(0, 1, At, B1); PG8_BAR; PG8_SCHED;
            PG8_LDA(At, 1, 1); PG8_STAGE(PG8_SB(1, 0), b3, voffB); PG8_STAGE(PG8_SB(1, 1), b3 + hstep, voffB); PG8_STAGE(PG8_SA(1, 0), a3, voffA);
            PG8_WAIT_V(8); PG8_WAIT_L(0); PG8_BAR; PG8_MMA(1, 0, At, B0); PG8_MMA(1, 1, At, B1); PG8_BAR; PG8_SCHED;
            } else {
            PG8_LDB(B0, 0, 0); PG8_SCHED; PG8_LDA(At, 0, 0); PG8_STAGE(PG8_SA(1, 1), a1 + hstep, voffA);
            PG8_WAIT_L(8); PG8_BAR; PG8_WAIT_L(0); PG8_MMA(0, 0, At, B0); PG8_BAR; PG8_SCHED;
            PG8_LDB(B1, 0, 1); PG8_STAGE(PG8_SB(0, 0), b2, voffB);
            PG8_BAR; PG8_WAIT_L(0); PG8_MMA(0, 1, At, B1); PG8_BAR;
            PG8_LDA(At, 0, 1); PG8_STAGE(PG8_SA(0, 0), a2, voffA);
            PG8_BAR; PG8_WAIT_L(0); PG8_MMA(1, 0, At, B0); PG8_BAR; PG8_SCHED;
            PG8_STAGE(PG8_SB(0, 1), b2 + hstep, voffB);
            PG8_WAIT_V(6); PG8_BAR; PG8_MMA(1, 1, At, B1); PG8_BAR;
            PG8_LDB(B0, 1, 0); PG8_SCHED; PG8_LDA(At, 1, 0); PG8_STAGE(PG8_SA(0, 1), a2 + hstep, voffA);
            PG8_WAIT_L(8); PG8_BAR; PG8_WAIT_L(0); PG8_MMA(0, 0, At, B0); PG8_BAR; PG8_SCHED;
            PG8_LDB(B1, 1, 1); PG8_STAGE(PG8_SB(1, 0), b3, voffB);
            PG8_BAR; PG8_WAIT_L(0); PG8_MMA(0, 1, At, B1); PG8_BAR;
            PG8_LDA(At, 1, 1); PG8_STAGE(PG8_SA(1, 0), a3, voffA);
            PG8_BAR; PG8_WAIT_L(0); PG8_MMA(1, 0, At, B0); PG8_BAR; PG8_SCHED;
            PG8_STAGE(PG8_SB(1, 1), b3 + hstep, voffB);
            PG8_WAIT_V(6); PG8_BAR; PG8_MMA(1, 1, At, B1); PG8_BAR;
            }
        }
        if constexpr (ALIGN_EPI) { if (wr == 0) PG8_BAR; }
        if constexpr (!Epi::AFTER_DRAIN) { E(acc, cur, wr, wc, fr, fq); S.done(cur); }
        if (!has_next) break;
#pragma unroll
        for (int a = 0; a < 2; ++a)
#pragma unroll
            for (int b = 0; b < 2; ++b)
#pragma unroll
                for (int m = 0; m < 4; ++m)
#pragma unroll
                    for (int n = 0; n < 2; ++n) acc[a][b][m][n] = (f32x4){0.f, 0.f, 0.f, 0.f};
        cur = nxt; cA = nA; cB = nB; ++ui;
        if constexpr (ALIGN_EPI) { if (wr == 1) PG8_BAR; }
    }
    PG8_WAIT_V(0);
    if constexpr (!ALIGN_EPI) { if (wr == 0) PG8_BAR; }
    PG8_BAR;
    if constexpr (Epi::AFTER_DRAIN) { E.fused(acc, cur, wr, wc, fr, fq, lds, wid, lane); S.done(cur); }
#undef PG8_SA
#undef PG8_SB
#undef PG8_STAGE
#undef PG8_LDA
#undef PG8_LDB
#undef PG8_MMA
#undef PG8_WAIT_V
#undef PG8_WAIT_L
#undef PG8_BAR
#undef PG8_SCHED
}
}

#define LAS __attribute__((address_space(3)))
typedef unsigned short bf16;
typedef unsigned v4u __attribute__((ext_vector_type(4)));
typedef unsigned v2u __attribute__((ext_vector_type(2)));
typedef float f32x4 __attribute__((ext_vector_type(4)));
typedef short bf16x8 __attribute__((ext_vector_type(8)));

#ifndef ONE_LAUNCH
#define ONE_LAUNCH 1
#endif

constexpr int DM = 2048, NTOK = 9216, NPT = 8192, TP = 2048;
constexpr int ABNP = 7424;
constexpr int C_BRAW = 3072, C_ARAW = 3080, C_ZA = 3088, C_QB = 4112, C_KB = 4624, C_VB = 5136, C_LR = 6160, C_ZB = 6176;
constexpr float EPS = 1e-6f;
constexpr int NPHASE = 23;
constexpr int LDS_BYTES = 147456;

constexpr size_t O_YP = 0;
constexpr size_t O_YS = O_YP + (size_t)4 * 2048 * 2048;
constexpr size_t O_PDELTA = O_YS + (size_t)128 * 8 * 2048;
constexpr size_t O_PDCONV = O_PDELTA + (size_t)2 * 4 * 8 * 128 * 128;
constexpr size_t O_PGLA = O_PDCONV + (size_t)2 * 4 * 3 * 3072;
constexpr size_t O_PLRU = O_PGLA + (size_t)2 * 4 * 4 * 128 * 256;
constexpr size_t O_PLCONV = O_PLRU + (size_t)2 * 4 * 2048;
constexpr size_t O_SDELTA = O_PLCONV + (size_t)2 * 4 * 3 * 2048;
constexpr size_t O_SDCONV = O_SDELTA + (size_t)2 * 128 * 8 * 128 * 128;
constexpr size_t O_SGLA = O_SDCONV + (size_t)2 * 128 * 3 * 3072;
constexpr size_t O_SLRU = O_SGLA + (size_t)2 * 128 * 4 * 128 * 256;
constexpr size_t O_SLCONV = O_SLRU + (size_t)2 * 128 * 2048;
constexpr size_t O_END = O_SLCONV + (size_t)2 * 128 * 3 * 2048;
static_assert(O_END == 92676096, "output size");

constexpr size_t MiB = 1u << 20;
constexpr size_t WS_WABIN = 1 * MiB;
constexpr size_t WS_WABOUT = WS_WABIN + 58 * MiB;
constexpr size_t WS_WLIN = WS_WABOUT + 16 * MiB;
constexpr size_t WS_WLOUT = WS_WLIN + 32 * MiB;
constexpr size_t WS_WLA = WS_WLOUT + 16 * MiB;
constexpr size_t WS_WLX = WS_WLA + 1 * MiB;
constexpr size_t WS_X = WS_WLX + 1 * MiB;
constexpr size_t WS_H = WS_X + 72 * MiB;
constexpr size_t WS_O = WS_H + 36 * MiB;
constexpr size_t WS_PROJ = WS_O + 36 * MiB;
constexpr size_t WS_GW = WS_PROJ + 131 * MiB;
constexpr size_t WS_GQG = WS_GW + 16 * MiB;
constexpr size_t WS_GKDT = WS_GQG + 16 * MiB;
constexpr size_t WS_GQK = WS_GKDT + 16 * MiB;
constexpr size_t WS_GUT = WS_GQK + 8 * MiB;
constexpr size_t WS_LQG = WS_GUT + 32 * MiB;
constexpr size_t WS_LKDT = WS_LQG + 8 * MiB;
constexpr size_t WS_LA = WS_LKDT + 8 * MiB;
constexpr size_t WS_LVT = WS_LA + 4 * MiB;
constexpr size_t WS_GDEC = WS_LVT + 16 * MiB;
constexpr size_t WS_LDEC = WS_GDEC + 1 * MiB;
constexpr size_t WS_SUM = WS_LDEC + 1 * MiB;
constexpr size_t WS_CARRY = WS_SUM + 2 * MiB;
constexpr size_t WS_END = WS_CARRY + 4 * MiB;

struct Params { const float* in[28]; float* out; unsigned char* ws; int ph_lo, ph_hi; };

struct Ctx {
    const float* in[28];
    float* out;
    bf16 *WABIN, *WABOUT, *WLIN, *WLOUT, *WLA, *WLX;
    float* X; bf16 *H, *O, *PROJ;
    bf16 *G_W, *G_QG, *G_KDT, *G_QK; float* G_UT;
    bf16 *L_QG, *L_KDT, *L_A, *L_VT; float *G_DEC, *L_DEC, *SUM, *SS; unsigned long long* CARRY;
    int G;
};

__device__ __forceinline__ int otid() { int t = threadIdx.x; asm volatile("" : "+v"(t)); return t; }
__device__ __forceinline__ int obid() { int b = blockIdx.x; asm volatile("" : "+s"(b)); return b; }
__device__ __forceinline__ float bf2f(unsigned b) { return __uint_as_float(b << 16); }
__device__ __forceinline__ unsigned f2bf(float f) { return (__float_as_uint(f) + 0x8000u) >> 16; }
__device__ __forceinline__ unsigned pk2(float lo, float hi) { return __builtin_amdgcn_perm(__float_as_uint(hi) + 0x8000u, __float_as_uint(lo) + 0x8000u, 0x07060302u); }
__device__ __forceinline__ void unpack8(v4u w, float (&f)[8]) {
    f[0] = __uint_as_float(w.x << 16); f[1] = __uint_as_float(w.x & 0xffff0000u);
    f[2] = __uint_as_float(w.y << 16); f[3] = __uint_as_float(w.y & 0xffff0000u);
    f[4] = __uint_as_float(w.z << 16); f[5] = __uint_as_float(w.z & 0xffff0000u);
    f[6] = __uint_as_float(w.w << 16); f[7] = __uint_as_float(w.w & 0xffff0000u);
}
__device__ __forceinline__ v4u pack8(const float (&f)[8]) { v4u w; w.x = pk2(f[0], f[1]); w.y = pk2(f[2], f[3]); w.z = pk2(f[4], f[5]); w.w = pk2(f[6], f[7]); return w; }
__device__ __forceinline__ float sigmoidf_(float x) { return __builtin_amdgcn_rcpf(1.0f + __expf(-x)); }
__device__ __forceinline__ float siluf_(float x) { return x * __builtin_amdgcn_rcpf(1.0f + __expf(-x)); }
#define LDS_BARRIER() do { asm volatile("s_waitcnt lgkmcnt(0)" ::: "memory"); __builtin_amdgcn_s_barrier(); asm volatile("" ::: "memory"); } while (0)
__device__ __forceinline__ float softplusf_(float x) { const float e = __expf(fminf(x, 20.f)); const float sp = (e < 0.03f) ? e * (1.0f - e * (0.5f - e * 0.33333333f)) : __logf(1.0f + e); return x > 20.f ? x : sp; }
__device__ __forceinline__ float logsigmoidf_(float x) { return fminf(x, 0.f) - __logf(1.0f + __expf(-fabsf(x))); }
__device__ __forceinline__ float wave_sum(float v) {
#pragma unroll
    for (int o = 1; o < 64; o <<= 1) v += __shfl_xor(v, o);
    return v;
}

__device__ __forceinline__ int frag_off(int row, int col, int nkk) { return (((row >> 4) * nkk + (col >> 5)) * 64 + ((col >> 3) & 3) * 16 + (row & 15)) * 8 + (col & 7); }
__device__ __forceinline__ int ufrag_off(int v, int c) { return (((v >> 4) * 4 + (c >> 4)) * 64 + ((c >> 2) & 3) * 16 + (v & 15)) * 4 + (c & 3); }
template <bool FRAG = false>
__device__ __forceinline__ void transpose_item(const float* W, int K, int N, bf16* WT, LAS float* scr, int item, int lane) {
    const int nblk = N / 32, kb = item / nblk, nb = item % nblk, k0 = 64 * kb, n0 = 32 * nb;
    float tv[32];
#pragma unroll
    for (int i = 0; i < 32; ++i) { const int kk = 2 * i + (lane >> 5); tv[i] = W[(size_t)(k0 + kk) * N + n0 + (lane & 31)]; }
#pragma unroll
    for (int i = 0; i < 32; ++i) { const int kk = 2 * i + (lane >> 5); scr[kk * 33 + (lane & 31)] = tv[i]; }
    asm volatile("s_waitcnt lgkmcnt(0)" ::: "memory");
    const int c = lane & 7;
#pragma unroll
    for (int j = 0; j < 4; ++j) { const int n = (lane >> 3) + 8 * j; const LAS float* s = scr + (8 * c) * 33 + n;
        v4u o; o.x = pk2(s[0 * 33], s[1 * 33]); o.y = pk2(s[2 * 33], s[3 * 33]); o.z = pk2(s[4 * 33], s[5 * 33]); o.w = pk2(s[6 * 33], s[7 * 33]);
        if (FRAG) *(v4u*)(WT + frag_off(n0 + n, k0 + 8 * c, K / 32)) = o;
        else *(v4u*)(WT + (size_t)(n0 + n) * K + k0 + 8 * c) = o; }
    asm volatile("s_waitcnt lgkmcnt(0)" ::: "memory");
}

__device__ __forceinline__ void rms_phase_bf16(const float* baseP, const float* baseS, const float* gw, bf16* Hout, int gwave, int ngw, int lane) {
    for (int m = gwave; m < NTOK; m += ngw) {
        const float* xr = (m < NPT) ? baseP + (size_t)m * DM : baseS + (size_t)(m - NPT) * DM;
        f32x4 v[8]; float ss = 0.f;
#pragma unroll
        for (int j = 0; j < 8; ++j) { v[j] = *(const f32x4*)(xr + (lane + 64 * j) * 4); ss += (v[j].x * v[j].x + v[j].y * v[j].y) + (v[j].z * v[j].z + v[j].w * v[j].w); }
        const float rinv = rsqrtf(wave_sum(ss) * (1.0f / DM) + EPS);
#pragma unroll
        for (int j = 0; j < 8; ++j) { const f32x4 g = *(const f32x4*)(gw + (lane + 64 * j) * 4);
            v2u o; o.x = pk2(v[j].x * rinv * g.x, v[j].y * rinv * g.y); o.y = pk2(v[j].z * rinv * g.z, v[j].w * rinv * g.w);
            *(v2u*)(Hout + (size_t)m * DM + (lane + 64 * j) * 4) = o; }
    }
}
__device__ __forceinline__ void rms_phase_f32(const float* X, const float* gw, float* out, int gwave, int ngw, int lane) {
    for (int m = gwave; m < NTOK; m += ngw) {
        const float* xr = X + (size_t)m * DM;
        f32x4 v[8]; float ss = 0.f;
#pragma unroll
        for (int j = 0; j < 8; ++j) { v[j] = *(const f32x4*)(xr + (lane + 64 * j) * 4); ss += (v[j].x * v[j].x + v[j].y * v[j].y) + (v[j].z * v[j].z + v[j].w * v[j].w); }
        const float rinv = rsqrtf(wave_sum(ss) * (1.0f / DM) + EPS);
#pragma unroll
        for (int j = 0; j < 8; ++j) { const f32x4 g = *(const f32x4*)(gw + (lane + 64 * j) * 4);
            f32x4 o; o.x = v[j].x * rinv * g.x; o.y = v[j].y * rinv * g.y; o.z = v[j].z * rinv * g.z; o.w = v[j].w * rinv * g.w;
            *(f32x4*)(out + (size_t)m * DM + (lane + 64 * j) * 4) = o; }
    }
}

constexpr int I_ABIN = 32 * 225, I_SQ = 32 * 64, I_LIN = 32 * 128, I_BLK = 2 * 4;
constexpr int OFF_ABOUT = 2 * I_ABIN, OFF_LIN = OFF_ABOUT + 2 * I_SQ, OFF_LOUT = OFF_LIN + 2 * I_LIN, OFF_WL = OFF_LOUT + 2 * I_SQ;
__device__ __forceinline__ void convert_item(const Ctx& C, int it, LAS float* scr, int lane) {
    int r = it;
    if (r < 2 * I_ABIN) { const int l = r / I_ABIN; r -= l * I_ABIN; transpose_item(C.in[8] + (size_t)l * 2048 * 7200, 2048, 7200, C.WABIN + (size_t)l * ABNP * 2048, scr, r, lane); return; } r -= 2 * I_ABIN;
    if (r < 2 * I_SQ) { const int l = r / I_SQ; r -= l * I_SQ; transpose_item(C.in[16] + (size_t)l * 2048 * 2048, 2048, 2048, C.WABOUT + (size_t)l * 2048 * 2048, scr, r, lane); return; } r -= 2 * I_SQ;
    if (r < 2 * I_LIN) { const int l = r / I_LIN; r -= l * I_LIN; transpose_item(C.in[18] + (size_t)l * 2048 * 4096, 2048, 4096, C.WLIN + (size_t)l * 4096 * 2048, scr, r, lane); return; } r -= 2 * I_LIN;
    if (r < 2 * I_SQ) { const int l = r / I_SQ; r -= l * I_SQ; transpose_item(C.in[26] + (size_t)l * 2048 * 2048, 2048, 2048, C.WLOUT + (size_t)l * 2048 * 2048, scr, r, lane); return; } r -= 2 * I_SQ;
    { const int which = r / (32 * I_BLK); r -= which * 32 * I_BLK; const int blk = r / I_BLK; r -= blk * I_BLK;
      transpose_item<true>((which ? C.in[23] : C.in[21]) + (size_t)blk * 16384, 128, 128, (which ? C.WLX : C.WLA) + (size_t)blk * 16384, scr, r, lane); }
}
__device__ __forceinline__ void convert_range(const Ctx& C, LAS float* scr, int lo, int hi, int wv, int nw, int lane) {
    if (wv < 0) return;
    for (int it = lo + wv; it < hi; it += nw) convert_item(C, it, scr, lane);
}
__device__ __forceinline__ void convert_segment(const Ctx& C, LAS unsigned char* lds, int seg, int first_idle_block) {
    const int tid = otid(), lane = tid & 63, wave = tid >> 6, bidx = obid();
    if (bidx < first_idle_block) return;
    LAS float* scr = (LAS float*)(lds + wave * 16384);
    const int wv = (bidx - first_idle_block) * 8 + wave, nw = (C.G - first_idle_block) * 8;
    if (seg == 1) {
        convert_range(C, scr, OFF_ABOUT, OFF_ABOUT + I_SQ, wv, nw, lane);
        convert_range(C, scr, OFF_LIN, OFF_LIN + I_LIN, wv, nw, lane);
        convert_range(C, scr, OFF_LOUT, OFF_LOUT + I_SQ, wv, nw, lane);
        convert_range(C, scr, OFF_WL, OFF_WL + 128, wv, nw, lane);
        convert_range(C, scr, OFF_WL + 256, OFF_WL + 384, wv, nw, lane);
    } else if (seg == 2) {
        convert_range(C, scr, I_ABIN, 2 * I_ABIN, wv, nw, lane);
    } else if (seg == 3) {
        convert_range(C, scr, OFF_ABOUT + I_SQ, OFF_ABOUT + 2 * I_SQ, wv, nw, lane);
        convert_range(C, scr, OFF_LIN + I_LIN, OFF_LIN + 2 * I_LIN, wv, nw, lane);
        convert_range(C, scr, OFF_WL + 128, OFF_WL + 256, wv, nw, lane);
        convert_range(C, scr, OFF_WL + 384, OFF_WL + 512, wv, nw, lane);
    } else {
        convert_range(C, scr, OFF_LOUT + I_SQ, OFF_LOUT + 2 * I_SQ, wv, nw, lane);
    }
}
__device__ __forceinline__ void prologue_phase(const Ctx& C, LAS unsigned char* lds) {
    const int tid = otid(), lane = tid & 63, wave = tid >> 6;
    LAS float* scr = (LAS float*)(lds + wave * 16384);
    const int bidx = obid(); const int gw = bidx * 8 + wave, NGW = C.G * 8;
    convert_range(C, scr, 0, (C.G == 256) ? I_ABIN : OFF_WL + 512, gw, NGW, lane);
    { const int gt = bidx * 512 + tid, ngt = C.G * 512; constexpr int PADV = 224 * 2048 / 8;
      for (int i = gt; i < 2 * PADV; i += ngt) { const int l = i / PADV, j = i % PADV; *(v4u*)(C.WABIN + (size_t)l * ABNP * 2048 + (size_t)7200 * 2048 + (size_t)j * 8) = (v4u){0u, 0u, 0u, 0u}; } }
    rms_phase_bf16(C.in[0], C.in[1], C.in[7], C.H, gw, NGW, lane);
}

__device__ __forceinline__ void gdn_prep_item(const Ctx& C, int layer, int item, LAS unsigned char* lds) {
    const int tid = otid(), lane = tid & 63, wid = tid >> 6, l15 = lane & 15, quad = lane >> 4;
    const int n = item & 31, h = (item >> 5) & 7, b = item >> 8;
    const size_t ch = (size_t)n * 32 + (item >> 5);
    LAS float* sQ = (LAS float*)lds;
    LAS float* sK = sQ + 64 * 132;
    LAS float* sV = sK + 64 * 132;
    LAS float* sA = sV + 64 * 132;
    LAS float* sBeta = sA + 64 * 64;
    LAS float* sG = sBeta + 64;
    LAS bf16* sQKb = (LAS bf16*)(sG + 64);
    const bf16* proj = C.PROJ;
    const float* cw = C.in[9] + (size_t)layer * 4 * 3072;
#pragma unroll 2
    for (int idx = tid; idx < 3072; idx += 512) {
        const int r = idx / 48, cg = idx % 48, part = cg >> 4, c8 = (cg & 15) * 8;
        const int col = part * 1024 + h * 128 + c8;
        float acc[8];
#pragma unroll
        for (int e = 0; e < 8; ++e) acc[e] = 0.f;
#pragma unroll
        for (int j = 0; j < 4; ++j) {
            const int t = n * 64 + r - 3 + j;
            if (t >= 0) {
                const v4u w = *(const v4u*)(proj + (size_t)(b * TP + t) * ABNP + col);
                float x[8]; unpack8(w, x);
                const f32x4 w0 = *(const f32x4*)(cw + j * 3072 + col), w1 = *(const f32x4*)(cw + j * 3072 + col + 4);
                acc[0] += x[0] * w0.x; acc[1] += x[1] * w0.y; acc[2] += x[2] * w0.z; acc[3] += x[3] * w0.w;
                acc[4] += x[4] * w1.x; acc[5] += x[5] * w1.y; acc[6] += x[6] * w1.z; acc[7] += x[7] * w1.w;
                if (j == 3 && n == 31 && r >= 61) {
                    float* o = C.out + O_PDCONV + ((size_t)(layer * 4 + b) * 3 + (r - 61)) * 3072 + col;
                    *(f32x4*)o = (f32x4){x[0], x[1], x[2], x[3]}; *(f32x4*)(o + 4) = (f32x4){x[4], x[5], x[6], x[7]};
                }
            }
        }
        LAS float* dst = (part == 0 ? sQ : (part == 1 ? sK : sV)) + r * 132 + c8;
        *(LAS f32x4*)dst = (f32x4){siluf_(acc[0]), siluf_(acc[1]), siluf_(acc[2]), siluf_(acc[3])};
        *(LAS f32x4*)(dst + 4) = (f32x4){siluf_(acc[4]), siluf_(acc[5]), siluf_(acc[6]), siluf_(acc[7])};
    }
    __syncthreads();
#pragma unroll
    for (int rr = 0; rr < 8; ++rr) {
        const int r = wid * 8 + rr;
        { const float a0 = sQ[r * 132 + lane], a1 = sQ[r * 132 + 64 + lane]; const float sc = rsqrtf(wave_sum(a0 * a0 + a1 * a1) + EPS) * 0.08838834764831845f;
          sQ[r * 132 + lane] = a0 * sc; sQ[r * 132 + 64 + lane] = a1 * sc; }
        { const float a0 = sK[r * 132 + lane], a1 = sK[r * 132 + 64 + lane]; const float sc = rsqrtf(wave_sum(a0 * a0 + a1 * a1) + EPS);
          sK[r * 132 + lane] = a0 * sc; sK[r * 132 + 64 + lane] = a1 * sc; }
    }
    if (tid < 64) {
        const size_t row = (size_t)(b * TP + n * 64 + tid);
        const float braw = bf2f(proj[row * ABNP + C_BRAW + h]), araw = bf2f(proj[row * ABNP + C_ARAW + h]);
        const float beta = sigmoidf_(braw);
        float g = -__expf(C.in[10][layer * 8 + h]) * softplusf_(araw + C.in[11][layer * 8 + h]);
#pragma unroll
        for (int o = 1; o < 64; o <<= 1) { const float t = __shfl_up(g, o); if (lane >= o) g += t; }
        sBeta[tid] = beta; sG[tid] = g;
    }
    __syncthreads();
    {
        const int mi = wid >> 1;
#pragma unroll
        for (int tt = 0; tt < 2; ++tt) {
            const int nj = (wid & 1) * 2 + tt;
            f32x4 accA = {0.f, 0.f, 0.f, 0.f}, accQ = {0.f, 0.f, 0.f, 0.f};
            if (nj <= mi) {
#pragma unroll
                for (int k16 = 0; k16 < 8; ++k16) {
                    const f32x4 ka = *(const LAS f32x4*)(sK + (mi * 16 + l15) * 132 + k16 * 16 + quad * 4);
                    const f32x4 qa = *(const LAS f32x4*)(sQ + (mi * 16 + l15) * 132 + k16 * 16 + quad * 4);
                    const f32x4 kb = *(const LAS f32x4*)(sK + (nj * 16 + l15) * 132 + k16 * 16 + quad * 4);
#pragma unroll
                    for (int s = 0; s < 4; ++s) {
                        accA = __builtin_amdgcn_mfma_f32_16x16x4f32(ka[s], kb[s], accA, 0, 0, 0);
                        accQ = __builtin_amdgcn_mfma_f32_16x16x4f32(qa[s], kb[s], accQ, 0, 0, 0);
                    }
                }
            }
            const int j = nj * 16 + l15; const float Gj = sG[j];
            f32x4 av;
#pragma unroll
            for (int jj = 0; jj < 4; ++jj) {
                const int i = mi * 16 + quad * 4 + jj;
                const float dec = (i >= j) ? __expf(sG[i] - Gj) : 0.f;
                av[jj] = (i > j) ? sBeta[i] * accA[jj] * dec : 0.f;
                sQKb[i * 72 + j] = (bf16)f2bf((i >= j) ? accQ[jj] * dec : 0.f);
            }
            if (nj <= mi) *(LAS f32x4*)(sA + j * 64 + mi * 16 + quad * 4) = av;
        }
    }
    __syncthreads();
    {
        const float gl = sG[63];
        for (int idx = tid; idx < 1024; idx += 512) {
            const int r = (idx >> 8) * 16 + (idx & 15), c8 = ((idx >> 6) & 3) * 32 + ((idx >> 4) & 3) * 8; const float eg = __expf(sG[r]);
            float v[8];
#pragma unroll
            for (int e = 0; e < 8; ++e) v[e] = sQ[r * 132 + c8 + e] * eg;
            *(v4u*)(C.G_QG + ch * 8192 + idx * 8) = pack8(v);
        }
        for (int idx = tid; idx < 1024; idx += 512) {
            const int k = (idx >> 7) * 16 + (idx & 15), i8 = ((idx >> 6) & 1) * 32 + ((idx >> 4) & 3) * 8;
            float v[8];
#pragma unroll
            for (int e = 0; e < 8; ++e) v[e] = sK[(i8 + e) * 132 + k] * __expf(gl - sG[i8 + e]);
            *(v4u*)(C.G_KDT + ch * 8192 + idx * 8) = pack8(v);
        }
        { const int idx = tid;
          const int r = (idx >> 7) * 16 + (idx & 15), c8 = ((idx >> 6) & 1) * 32 + ((idx >> 4) & 3) * 8;
          *(v4u*)(C.G_QK + ch * 4096 + idx * 8) = *(const LAS v4u*)(sQKb + r * 72 + c8); }
        if (tid == 0) C.G_DEC[ch] = __expf(gl);
    }
    __syncthreads();
    if (tid < 256) {
        const int c = tid;
        LAS float* colp = (c < 128) ? (sV + c) : (sK + (c - 128));
#pragma unroll 1
        for (int I = 0; I < 4; ++I) {
            float sl[16];
#pragma unroll
            for (int ii = 0; ii < 16; ++ii) { const int i = I * 16 + ii; const float f = (c < 128) ? sBeta[i] : sBeta[i] * __expf(sG[i]); sl[ii] = colp[i * 132] * f; }
#pragma unroll 4
            for (int j = 0; j < I * 16; ++j) {
                const float x = colp[j * 132];
                const LAS float* ap = sA + j * 64 + I * 16;
                const f32x4 a0 = *(const LAS f32x4*)ap, a1 = *(const LAS f32x4*)(ap + 4), a2 = *(const LAS f32x4*)(ap + 8), a3 = *(const LAS f32x4*)(ap + 12);
                sl[0] -= a0.x * x; sl[1] -= a0.y * x; sl[2] -= a0.z * x; sl[3] -= a0.w * x;
                sl[4] -= a1.x * x; sl[5] -= a1.y * x; sl[6] -= a1.z * x; sl[7] -= a1.w * x;
                sl[8] -= a2.x * x; sl[9] -= a2.y * x; sl[10] -= a2.z * x; sl[11] -= a2.w * x;
                sl[12] -= a3.x * x; sl[13] -= a3.y * x; sl[14] -= a3.z * x; sl[15] -= a3.w * x;
            }
#pragma unroll
            for (int jj = 0; jj < 15; ++jj) {
                const LAS float* ap = sA + (I * 16 + jj) * 64 + I * 16;
                float a[16];
#pragma unroll
                for (int q4 = 0; q4 < 4; ++q4) { const f32x4 t = *(const LAS f32x4*)(ap + q4 * 4); a[q4 * 4] = t.x; a[q4 * 4 + 1] = t.y; a[q4 * 4 + 2] = t.z; a[q4 * 4 + 3] = t.w; }
#pragma unroll
                for (int ii = jj + 1; ii < 16; ++ii) sl[ii] -= a[ii] * sl[jj];
            }
#pragma unroll
            for (int ii = 0; ii < 16; ++ii) colp[(I * 16 + ii) * 132] = sl[ii];
        }
    }
    __syncthreads();
    for (int idx = tid; idx < 1024; idx += 512) {
        const int r = (idx >> 8) * 16 + (idx & 15), c8 = ((idx >> 6) & 3) * 32 + ((idx >> 4) & 3) * 8;
        float v[8];
#pragma unroll
        for (int e = 0; e < 8; ++e) v[e] = sK[r * 132 + c8 + e];
        *(v4u*)(C.G_W + ch * 8192 + idx * 8) = pack8(v);
    }
    for (int idx = tid; idx < 2048; idx += 512) {
        const int v = (idx >> 8) * 16 + (idx & 15), c = ((idx >> 6) & 3) * 16 + ((idx >> 4) & 3) * 4;
        *(f32x4*)(C.G_UT + ch * 8192 + idx * 4) = (f32x4){sV[c * 132 + v], sV[(c + 1) * 132 + v], sV[(c + 2) * 132 + v], sV[(c + 3) * 132 + v]};
    }
    __syncthreads();
}

__device__ __forceinline__ void gla_prep_item(const Ctx& C, int layer, int item, LAS unsigned char* lds) {
    const int tid = otid(), lane = tid & 63, wid = tid >> 6, l15 = lane & 15, quad = lane >> 4;
    const int n = item & 31, h = (item >> 5) & 3, b = item >> 7;
    const size_t ch = (size_t)n * 16 + (item >> 5);
    const size_t tok0 = (size_t)b * TP + n * 64;
    LAS float* sQG = (LAS float*)lds;
    LAS float* sKN = sQG + 64 * 132;
    LAS float* sBc = sKN + 64 * 132;
    LAS float* sLR = sBc + 64 * 132;
    LAS bf16* sAb = (LAS bf16*)(sLR + 1024);
    const bf16* proj = C.PROJ;
    for (int idx = tid; idx < 1024; idx += 512) { const int r = idx >> 4, m = idx & 15; sLR[idx] = bf2f(proj[(tok0 + r) * ABNP + C_LR + m]); }
    __syncthreads();
    {
        const int k = tid & 127, rg = tid >> 7;
        float wl[16];
#pragma unroll
        for (int m = 0; m < 16; ++m) wl[m] = C.in[13][(size_t)(layer * 16 + m) * 512 + h * 128 + k];
        const float bl = C.in[14][layer * 512 + h * 128 + k];
        for (int r = rg * 16; r < rg * 16 + 16; ++r) {
            float x = bl;
#pragma unroll
            for (int m = 0; m < 16; ++m) x += sLR[r * 16 + m] * wl[m];
            sBc[r * 132 + k] = logsigmoidf_(x) * (1.0f / 16.0f);
        }
    }
    __syncthreads();
    if (tid < 128) { float acc = 0.f;
#pragma unroll 16
        for (int r = 0; r < 64; ++r) { acc += sBc[r * 132 + tid]; sBc[r * 132 + tid] = acc; } }
    __syncthreads();
    for (int idx = tid; idx < 1024; idx += 512) {
        const int r = idx >> 4, c8 = (idx & 15) * 8;
        float q[8], k[8], qg[8];
        unpack8(*(const v4u*)(proj + (tok0 + r) * ABNP + C_QB + h * 128 + c8), q);
        unpack8(*(const v4u*)(proj + (tok0 + r) * ABNP + C_KB + h * 128 + c8), k);
#pragma unroll
        for (int e = 0; e < 8; ++e) { const float bc = sBc[r * 132 + c8 + e]; qg[e] = q[e] * 0.08838834764831845f * __expf(bc); sQG[r * 132 + c8 + e] = qg[e]; sKN[r * 132 + c8 + e] = k[e] * __expf(-bc); }
    }
    for (int idx = tid; idx < 2048; idx += 512) {
        const int v = idx & 255, i8 = (idx >> 8) * 8;
        float x[8];
#pragma unroll
        for (int e = 0; e < 8; ++e) x[e] = bf2f(proj[(tok0 + i8 + e) * ABNP + C_VB + h * 256 + v]);
        *(v4u*)(C.L_VT + ch * 16384 + frag_off(v, i8, 2)) = pack8(x);
    }
    __syncthreads();
    for (int idx = tid; idx < 1024; idx += 512) {
        const int r = (idx >> 8) * 16 + (idx & 15), c8 = ((idx >> 6) & 3) * 32 + ((idx >> 4) & 3) * 8;
        float v[8];
#pragma unroll
        for (int e = 0; e < 8; ++e) v[e] = sQG[r * 132 + c8 + e];
        *(v4u*)(C.L_QG + ch * 8192 + idx * 8) = pack8(v);
    }
    for (int idx = tid; idx < 1024; idx += 512) {
        const int k = (idx >> 7) * 16 + (idx & 15), i8 = ((idx >> 6) & 1) * 32 + ((idx >> 4) & 3) * 8; const float ebl = __expf(sBc[63 * 132 + k]);
        float v[8];
#pragma unroll
        for (int e = 0; e < 8; ++e) v[e] = sKN[(i8 + e) * 132 + k] * ebl;
        *(v4u*)(C.L_KDT + ch * 8192 + idx * 8) = pack8(v);
    }
    if (tid < 128) C.L_DEC[ch * 128 + tid] = __expf(sBc[63 * 132 + tid]);
    {
        const int mi = wid >> 1;
#pragma unroll
        for (int tt = 0; tt < 2; ++tt) {
            const int nj = (wid & 1) * 2 + tt;
            f32x4 acc = {0.f, 0.f, 0.f, 0.f};
            if (nj <= mi) {
#pragma unroll
                for (int k16 = 0; k16 < 8; ++k16) {
                    const f32x4 qa = *(const LAS f32x4*)(sQG + (mi * 16 + l15) * 132 + k16 * 16 + quad * 4);
                    const f32x4 kb = *(const LAS f32x4*)(sKN + (nj * 16 + l15) * 132 + k16 * 16 + quad * 4);
#pragma unroll
                    for (int s = 0; s < 4; ++s) acc = __builtin_amdgcn_mfma_f32_16x16x4f32(qa[s], kb[s], acc, 0, 0, 0);
                }
            }
            const int j = nj * 16 + l15;
#pragma unroll
            for (int jj = 0; jj < 4; ++jj) { const int i = mi * 16 + quad * 4 + jj; sAb[i * 72 + j] = (bf16)f2bf((i >= j) ? acc[jj] : 0.f); }
        }
    }
    __syncthreads();
    { const int idx = tid;
      const int r = (idx >> 7) * 16 + (idx & 15), c8 = ((idx >> 6) & 1) * 32 + ((idx >> 4) & 3) * 8;
      *(v4u*)(C.L_A + ch * 4096 + idx * 8) = *(const LAS v4u*)(sAb + r * 72 + c8); }
    __syncthreads();
}

template <bool HAS_W> struct ScanFr { bf16x8 aq[4]; bf16x8 aw[4]; bf16x8 aqk[2]; bf16x8 ak[2][2]; bf16x8 bvg[2]; f32x4 u; f32x4 dec[2]; };
template <bool HAS_W>
__device__ __forceinline__ void scan_load(ScanFr<HAS_W>& F, const Ctx& C, size_t ch, int s, int mi, int ni, int kt0, int l15, int quad) {
    const int lane8 = (quad * 16 + l15) * 8;
    const bf16* QG = (HAS_W ? C.G_QG : C.L_QG) + ch * 8192 + lane8;
    const bf16* KDT = (HAS_W ? C.G_KDT : C.L_KDT) + ch * 8192 + lane8;
    const bf16* QK = (HAS_W ? C.G_QK : C.L_A) + ch * 4096 + lane8;
#pragma unroll
    for (int kk = 0; kk < 4; ++kk) {
        F.aq[kk] = *(const bf16x8*)(QG + (mi * 4 + kk) * 512);
        if (HAS_W) F.aw[kk] = *(const bf16x8*)(C.G_W + ch * 8192 + lane8 + (mi * 4 + kk) * 512);
    }
#pragma unroll
    for (int kk = 0; kk < 2; ++kk) {
        F.aqk[kk] = *(const bf16x8*)(QK + (mi * 2 + kk) * 512);
#pragma unroll
        for (int t = 0; t < 2; ++t) F.ak[t][kk] = *(const bf16x8*)(KDT + ((kt0 + t) * 2 + kk) * 512);
        if (!HAS_W) F.bvg[kk] = *(const bf16x8*)(C.L_VT + ch * 16384 + lane8 + ((s * 2 + ni) * 2 + kk) * 512);
    }
    if (HAS_W) {
        F.u = *(const f32x4*)(C.G_UT + ch * 8192 + (((s * 2 + ni) * 4 + mi) * 64 + quad * 16 + l15) * 4);
        const float d = C.G_DEC[ch]; F.dec[0] = (f32x4){d, d, d, d}; F.dec[1] = F.dec[0];
    } else {
#pragma unroll
        for (int t = 0; t < 2; ++t) F.dec[t] = *(const f32x4*)(C.L_DEC + ch * 128 + (kt0 + t) * 16 + quad * 4);
    }
}
template <bool HAS_W>
__device__ __forceinline__ void scan_step(const ScanFr<HAS_W>& F, f32x4 (&Sacc)[2], LAS bf16* sST, LAS bf16* sVT, LAS bf16* sO, int mi, int ni, int kt0, int l15, int quad) {
    f32x4 acc_o = {0.f, 0.f, 0.f, 0.f}, acc_w = {0.f, 0.f, 0.f, 0.f};
#pragma unroll
    for (int kk = 0; kk < 4; ++kk) {
        const bf16x8 bfr = *(const LAS bf16x8*)(sST + (ni * 16 + l15) * 136 + kk * 32 + quad * 8);
        acc_o = __builtin_amdgcn_mfma_f32_16x16x32_bf16(F.aq[kk], bfr, acc_o, 0, 0, 0);
        if (HAS_W) acc_w = __builtin_amdgcn_mfma_f32_16x16x32_bf16(F.aw[kk], bfr, acc_w, 0, 0, 0);
    }
    if (HAS_W) {
        const f32x4 vn = F.u - acc_w;
        v2u o; o.x = pk2(vn.x, vn.y); o.y = pk2(vn.z, vn.w);
        *(LAS v2u*)(sVT + (ni * 16 + l15) * 72 + mi * 16 + quad * 4) = o;
    }
    LDS_BARRIER();
    bf16x8 bv[2];
#pragma unroll
    for (int kk = 0; kk < 2; ++kk) {
        if (HAS_W) bv[kk] = *(const LAS bf16x8*)(sVT + (ni * 16 + l15) * 72 + kk * 32 + quad * 8);
        else bv[kk] = F.bvg[kk];
    }
#pragma unroll
    for (int kk = 0; kk < 2; ++kk) acc_o = __builtin_amdgcn_mfma_f32_16x16x32_bf16(F.aqk[kk], bv[kk], acc_o, 0, 0, 0);
#pragma unroll
    for (int j = 0; j < 4; ++j) sO[(mi * 16 + quad * 4 + j) * 40 + ni * 16 + l15] = (bf16)f2bf(acc_o[j]);
#pragma unroll
    for (int t = 0; t < 2; ++t) {
        Sacc[t] = Sacc[t] * F.dec[t];
#pragma unroll
        for (int kk = 0; kk < 2; ++kk) Sacc[t] = __builtin_amdgcn_mfma_f32_16x16x32_bf16(F.ak[t][kk], bv[kk], Sacc[t], 0, 0, 0);
        v2u o; o.x = pk2(Sacc[t].x, Sacc[t].y); o.y = pk2(Sacc[t].z, Sacc[t].w);
        *(LAS v2u*)(sST + (ni * 16 + l15) * 136 + (kt0 + t) * 16 + quad * 4) = o;
    }
    LDS_BARRIER();
}
template <bool HAS_W>
__device__ __forceinline__ void scan_task(const Ctx& C, int layer, int task, LAS unsigned char* lds) {
    const int tid = otid(), lane = tid & 63, w = tid >> 6, l15 = lane & 15, quad = lane >> 4;
    const int s = HAS_W ? (task & 3) : (task & 7), bh = HAS_W ? (task >> 2) : (task >> 3);
    const int b = HAS_W ? (bh >> 3) : (bh >> 2), h = HAS_W ? (bh & 7) : (bh & 3);
    const int mi = w >> 1, ni = w & 1, kt0 = (w >> 1) * 2;
    LAS bf16* sST = (LAS bf16*)lds;
    LAS bf16* sVT = sST + 32 * 136;
    LAS bf16* sO = sVT + 32 * 72;
    f32x4 Sacc[2]; Sacc[0] = (f32x4){0.f, 0.f, 0.f, 0.f}; Sacc[1] = Sacc[0];
    for (int i = tid; i < 32 * 136 / 2; i += 512) ((LAS unsigned*)sST)[i] = 0u;
    const int colbase = HAS_W ? (h * 128 + s * 32) : (1024 + h * 256 + s * 32);
    bf16* OA = C.H + (size_t)b * TP * DM + colbase;
    const int NBH = HAS_W ? 32 : 16;
    ScanFr<HAS_W> FA, FB;
    __syncthreads();
#pragma unroll 1
    for (int n = 0; n < 32; n += 2) {
        scan_load<HAS_W>(FA, C, (size_t)n * NBH + bh, s, mi, ni, kt0, l15, quad);
        scan_load<HAS_W>(FB, C, (size_t)(n + 1) * NBH + bh, s, mi, ni, kt0, l15, quad);
        scan_step<HAS_W>(FA, Sacc, sST, sVT, sO, mi, ni, kt0, l15, quad);
        scan_step<HAS_W>(FB, Sacc, sST, sVT, sO + 64 * 40, mi, ni, kt0, l15, quad);
        {
            const int r = tid >> 2, sgm = tid & 3;
            const v4u ov = *(const LAS v4u*)(sO + r * 40 + sgm * 8);
            *(v4u*)(OA + (size_t)(n * 64 + r) * DM + sgm * 8) = ov;
        }
    }
    const int DV = HAS_W ? 128 : 256;
    float* outS = C.out + (HAS_W ? O_PDELTA + (size_t)((layer * 4 + b) * 8 + h) * 128 * 128 : O_PGLA + (size_t)((layer * 4 + b) * 4 + h) * 128 * 256);
#pragma unroll
    for (int t = 0; t < 2; ++t)
#pragma unroll
        for (int j = 0; j < 4; ++j) outS[(size_t)((kt0 + t) * 16 + quad * 4 + j) * DV + s * 32 + ni * 16 + l15] = Sacc[t][j];
    __syncthreads();
}

__device__ __forceinline__ void gdn_sample_item(const Ctx& C, int layer, int item, LAS unsigned char* lds) {
    const int tid = otid(), lane = tid & 63, wid = tid >> 6;
    const int h = item & 7, b = item >> 3;
    LAS float* sq = (LAS float*)lds;
    LAS float* sk = sq + 1024;
    LAS float* sv = sk + 1024;
    LAS float* so = sv + 1024;
    LAS float* red = so + 1024;
    LAS float* red2 = red + 512;
    LAS float* sbeta = red2 + 512;
    LAS float* seg = sbeta + 8;
    const bf16* proj = C.PROJ;
    const size_t tokS = (size_t)NPT + b * 8;
    const float* cw = C.in[9] + (size_t)layer * 4 * 3072;
    if (tid < 384) {
        const int t = tid / 48, cg = tid % 48, part = cg >> 4, c8 = (cg & 15) * 8;
        const int col = part * 1024 + h * 128 + c8;
        float acc[8];
#pragma unroll
        for (int e = 0; e < 8; ++e) acc[e] = 0.f;
#pragma unroll
        for (int j = 0; j < 4; ++j) {
            const int tl = t - 3 + j;
            float x[8];
            if (tl >= 0) unpack8(*(const v4u*)(proj + (tokS + tl) * ABNP + col), x);
            else { const float* sp = C.in[3] + ((size_t)(layer * 128 + b) * 3 + (3 + tl)) * 3072 + col;
                const f32x4 a = *(const f32x4*)sp, c = *(const f32x4*)(sp + 4); x[0] = a.x; x[1] = a.y; x[2] = a.z; x[3] = a.w; x[4] = c.x; x[5] = c.y; x[6] = c.z; x[7] = c.w; }
            const f32x4 w0 = *(const f32x4*)(cw + j * 3072 + col), w1 = *(const f32x4*)(cw + j * 3072 + col + 4);
            acc[0] += x[0] * w0.x; acc[1] += x[1] * w0.y; acc[2] += x[2] * w0.z; acc[3] += x[3] * w0.w;
            acc[4] += x[4] * w1.x; acc[5] += x[5] * w1.y; acc[6] += x[6] * w1.z; acc[7] += x[7] * w1.w;
            if (j == 3 && t >= 5) {
                float* o = C.out + O_SDCONV + ((size_t)(layer * 128 + b) * 3 + (t - 5)) * 3072 + col;
                *(f32x4*)o = (f32x4){x[0], x[1], x[2], x[3]}; *(f32x4*)(o + 4) = (f32x4){x[4], x[5], x[6], x[7]};
            }
        }
        LAS float* dst = (part == 0 ? sq : (part == 1 ? sk : sv)) + t * 128 + c8;
        *(LAS f32x4*)dst = (f32x4){siluf_(acc[0]), siluf_(acc[1]), siluf_(acc[2]), siluf_(acc[3])};
        *(LAS f32x4*)(dst + 4) = (f32x4){siluf_(acc[4]), siluf_(acc[5]), siluf_(acc[6]), siluf_(acc[7])};
    }
    __syncthreads();
    {
        const int r = wid;
        { const float a0 = sq[r * 128 + lane], a1 = sq[r * 128 + 64 + lane]; const float sc = rsqrtf(wave_sum(a0 * a0 + a1 * a1) + EPS) * 0.08838834764831845f;
          sq[r * 128 + lane] = a0 * sc; sq[r * 128 + 64 + lane] = a1 * sc; }
        { const float a0 = sk[r * 128 + lane], a1 = sk[r * 128 + 64 + lane]; const float sc = rsqrtf(wave_sum(a0 * a0 + a1 * a1) + EPS);
          sk[r * 128 + lane] = a0 * sc; sk[r * 128 + 64 + lane] = a1 * sc; }
        if (tid < 8) {
            const float braw = bf2f(proj[(tokS + tid) * ABNP + C_BRAW + h]), araw = bf2f(proj[(tokS + tid) * ABNP + C_ARAW + h]);
            sbeta[tid] = sigmoidf_(braw);
            seg[tid] = __expf(-__expf(C.in[10][layer * 8 + h]) * softplusf_(araw + C.in[11][layer * 8 + h]));
        }
    }
    const int v = tid & 127, kg = tid >> 7;
    float S[32];
    { const float* sp = C.in[2] + ((size_t)((layer * 128 + b) * 8 + h) * 128 + kg * 32) * 128 + v;
#pragma unroll
      for (int i = 0; i < 32; ++i) S[i] = __builtin_nontemporal_load(sp + (size_t)i * 128); }
    __syncthreads();
    for (int t = 0; t < 8; ++t) {
        const float eg = seg[t];
        float p = 0.f;
#pragma unroll
        for (int i = 0; i < 32; ++i) p += S[i] * sk[t * 128 + kg * 32 + i];
        red[kg * 128 + v] = p;
        __syncthreads();
        const float r = (red[v] + red[128 + v]) + (red[256 + v] + red[384 + v]);
        const float vn = sbeta[t] * (sv[t * 128 + v] - eg * r);
        float po = 0.f;
#pragma unroll
        for (int i = 0; i < 32; ++i) { S[i] = eg * S[i] + sk[t * 128 + kg * 32 + i] * vn; po += S[i] * sq[t * 128 + kg * 32 + i]; }
        red2[kg * 128 + v] = po;
        __syncthreads();
        if (kg == 0) so[t * 128 + v] = (red2[v] + red2[128 + v]) + (red2[256 + v] + red2[384 + v]);
    }
    { float* op = C.out + O_SDELTA + ((size_t)((layer * 128 + b) * 8 + h) * 128 + kg * 32) * 128 + v;
#pragma unroll
      for (int i = 0; i < 32; ++i) __builtin_nontemporal_store(S[i], op + (size_t)i * 128); }
    __syncthreads();
    {
        const int t = wid;
        const float o0 = so[t * 128 + lane], o1 = so[t * 128 + 64 + lane];
        const float rstd = rsqrtf(wave_sum(o0 * o0 + o1 * o1) * (1.0f / 128.0f) + EPS);
        const float* nw = C.in[12] + layer * 128;
        const float z0 = bf2f(proj[(tokS + t) * ABNP + C_ZA + h * 128 + lane]), z1 = bf2f(proj[(tokS + t) * ABNP + C_ZA + h * 128 + 64 + lane]);
        C.O[(tokS + t) * DM + h * 128 + lane] = (bf16)f2bf(o0 * rstd * nw[lane] * siluf_(z0));
        C.O[(tokS + t) * DM + h * 128 + 64 + lane] = (bf16)f2bf(o1 * rstd * nw[64 + lane] * siluf_(z1));
    }
    __syncthreads();
}

__device__ __forceinline__ void gla_sample_item(const Ctx& C, int layer, int item, LAS unsigned char* lds) {
    const int tid = otid(), lane = tid & 63, wid = tid >> 6;
    const int h = item & 3, b = item >> 2;
    LAS float* sq = (LAS float*)lds;
    LAS float* sk = sq + 1024;
    LAS float* sgk = sk + 1024;
    LAS float* sv = sgk + 1024;
    LAS float* so = sv + 2048;
    LAS float* red = so + 2048;
    LAS float* slr = red + 4096;
    const bf16* proj = C.PROJ;
    const size_t tokS = (size_t)NPT + b * 8;
    if (tid < 128) slr[tid] = bf2f(proj[(tokS + (tid >> 4)) * ABNP + C_LR + (tid & 15)]);
    for (int idx = tid; idx < 1024; idx += 512) { const int t = idx >> 7, k = idx & 127;
        sq[idx] = bf2f(proj[(tokS + t) * ABNP + C_QB + h * 128 + k]) * 0.08838834764831845f; sk[idx] = bf2f(proj[(tokS + t) * ABNP + C_KB + h * 128 + k]); }
    for (int idx = tid; idx < 2048; idx += 512) { const int t = idx >> 8, vv = idx & 255; sv[idx] = bf2f(proj[(tokS + t) * ABNP + C_VB + h * 256 + vv]); }
    __syncthreads();
    for (int idx = tid; idx < 1024; idx += 512) { const int t = idx >> 7, k = idx & 127;
        float x = C.in[14][layer * 512 + h * 128 + k];
#pragma unroll
        for (int m = 0; m < 16; ++m) x += slr[t * 16 + m] * C.in[13][(size_t)(layer * 16 + m) * 512 + h * 128 + k];
        sgk[idx] = __expf(logsigmoidf_(x) * (1.0f / 16.0f)); }
    const int v4 = (tid & 63) * 4, k0 = (tid >> 6) * 16;
    f32x4 S[16];
    { const float* sp = C.in[4] + ((size_t)((layer * 128 + b) * 4 + h) * 128 + k0) * 256 + v4;
#pragma unroll
      for (int i = 0; i < 16; ++i) S[i] = __builtin_nontemporal_load((const f32x4*)(sp + (size_t)i * 256)); }
    __syncthreads();
    LAS float* red8 = red;
    for (int t = 0; t < 8; ++t) {
        const f32x4 vt = *(const LAS f32x4*)(sv + t * 256 + v4);
        f32x4 po = {0.f, 0.f, 0.f, 0.f};
#pragma unroll
        for (int i4 = 0; i4 < 4; ++i4) {
            const f32x4 g4 = *(const LAS f32x4*)(sgk + t * 128 + k0 + i4 * 4), kk4 = *(const LAS f32x4*)(sk + t * 128 + k0 + i4 * 4), q4 = *(const LAS f32x4*)(sq + t * 128 + k0 + i4 * 4);
#pragma unroll
            for (int e = 0; e < 4; ++e) { const int i = i4 * 4 + e; S[i] = S[i] * g4[e] + vt * kk4[e]; po = po + S[i] * q4[e]; }
        }
        *(LAS f32x4*)(red8 + (t & 1) * 2048 + (tid >> 6) * 256 + v4) = po;
        __syncthreads();
        if (tid < 256) { float a = 0.f;
#pragma unroll
            for (int g = 0; g < 8; ++g) a += red8[(t & 1) * 2048 + g * 256 + tid];
            so[t * 256 + tid] = a; }
    }
    { float* op = C.out + O_SGLA + ((size_t)((layer * 128 + b) * 4 + h) * 128 + k0) * 256 + v4;
#pragma unroll
      for (int i = 0; i < 16; ++i) __builtin_nontemporal_store(S[i], (f32x4*)(op + (size_t)i * 256)); }
    __syncthreads();
    {
        const int t = wid;
        float o[4], ss = 0.f;
#pragma unroll
        for (int e = 0; e < 4; ++e) { o[e] = so[t * 256 + e * 64 + lane]; ss += o[e] * o[e]; }
        const float rstd = rsqrtf(wave_sum(ss) * (1.0f / 256.0f) + EPS);
        const float* nw = C.in[15] + layer * 256;
#pragma unroll
        for (int e = 0; e < 4; ++e) { const int vv = e * 64 + lane; const float z = bf2f(proj[(tokS + t) * ABNP + C_ZB + h * 256 + vv]);
            C.O[(tokS + t) * DM + 1024 + h * 256 + vv] = (bf16)f2bf(o[e] * rstd * nw[vv] * siluf_(z)); }
    }
    __syncthreads();
}

__device__ __forceinline__ void gatenorm_phase(const Ctx& C, int layer, int gwave, int ngw, int lane) {
    const bf16* OA = C.H;
    for (int m = gwave; m < NPT; m += ngw) {
#pragma unroll
        for (int st = 0; st < 4; ++st) {
            const int c0 = st * 512 + lane * 8;
            float o[8], z[8];
            unpack8(*(const v4u*)(OA + (size_t)m * DM + c0), o);
            const bool gdn = st < 2;
            const int zc = gdn ? (C_ZA + c0) : (C_ZB + (c0 - 1024));
            unpack8(*(const v4u*)(C.PROJ + (size_t)m * ABNP + zc), z);
            float ss = 0.f;
#pragma unroll
            for (int e = 0; e < 8; ++e) ss += o[e] * o[e];
            ss += __shfl_xor(ss, 1); ss += __shfl_xor(ss, 2); ss += __shfl_xor(ss, 4); ss += __shfl_xor(ss, 8);
            if (!gdn) ss += __shfl_xor(ss, 16);
            const float rstd = rsqrtf(ss * (gdn ? (1.0f / 128.0f) : (1.0f / 256.0f)) + EPS);
            const float* nw = gdn ? (C.in[12] + layer * 128 + (c0 & 127)) : (C.in[15] + layer * 256 + ((c0 - 1024) & 255));
            const f32x4 n0 = *(const f32x4*)nw, n1 = *(const f32x4*)(nw + 4);
            float r[8];
            r[0] = o[0] * rstd * n0.x * siluf_(z[0]); r[1] = o[1] * rstd * n0.y * siluf_(z[1]); r[2] = o[2] * rstd * n0.z * siluf_(z[2]); r[3] = o[3] * rstd * n0.w * siluf_(z[3]);
            r[4] = o[4] * rstd * n1.x * siluf_(z[4]); r[5] = o[5] * rstd * n1.y * siluf_(z[5]); r[6] = o[6] * rstd * n1.z * siluf_(z[6]); r[7] = o[7] * rstd * n1.w * siluf_(z[7]);
            *(v4u*)(C.O + (size_t)m * DM + c0) = pack8(r);
        }
    }
}

template <int PASS>
__device__ __forceinline__ void lru_item(const Ctx& C, int jl, int item, LAS unsigned char* lds) {
    const int tid = otid(), lane = tid & 63, w = tid >> 6, l15 = lane & 15, quad = lane >> 4;
    const bool sample = item >= 2048;
    const int it2 = sample ? item - 2048 : item;
    const int n = it2 & 15;
    const int chunk = sample ? 0 : (PASS == 3 ? (it2 >> 6) : ((it2 >> 4) & 31)), b = sample ? 0 : (PASS == 3 ? ((it2 >> 4) & 3) : (it2 >> 9)), bg = sample ? (it2 >> 4) : 0;
    const size_t tok0 = sample ? (size_t)NPT + bg * 64 : (size_t)b * TP + chunk * 64;
    LAS float* sXC = (LAS float*)lds;
    LAS float* sAa = sXC + 64 * 132;
    LAS float* sBb = sAa + 64 * 132;
    LAS float* sSegP = sBb + 64 * 132;
    LAS float* sSegH = sSegP + 1024;
    LAS float* sCarry = sSegH + 1024;
    LAS bf16* sXB = (LAS bf16*)(sCarry + 128);
    LAS float* sCP = (LAS float*)(sXB + 64 * 136);
    LAS float* sCH = sCP + 512;
    const bf16* proj = C.PROJ;
    const float* cw = C.in[19] + (size_t)jl * 4 * 2048;
    const int col = tid & 127, sg0 = tid >> 7;
    const int d = w * 16 + l15, chd = n * 128 + d;
    bf16x8 bA[4], bX[4];
#pragma unroll
    for (int kk = 0; kk < 4; ++kk) {
        bA[kk] = *(const bf16x8*)(C.WLA + (size_t)(jl * 16 + n) * 16384 + ((w * 4 + kk) * 64 + lane) * 8);
        bX[kk] = *(const bf16x8*)(C.WLX + (size_t)(jl * 16 + n) * 16384 + ((w * 4 + kk) * 64 + lane) * 8);
    }
    const float ba = C.in[22][jl * 2048 + chd], bx_ = C.in[24][jl * 2048 + chd], lam = C.in[25][jl * 2048 + chd];
    unsigned short gt[16]; float h0[2] = {0.f, 0.f};
    if (PASS >= 2) {
#pragma unroll
        for (int q = 0; q < 2; ++q) {
            const int sgm = sg0 + 4 * q;
#pragma unroll
            for (int r8 = 0; r8 < 8; ++r8) gt[q * 8 + r8] = proj[(tok0 + sgm * 8 + r8) * 4096 + 2048 + n * 128 + col];
            if (sample) h0[q] = C.in[5][(size_t)(jl * 128 + bg * 8 + sgm) * 2048 + n * 128 + col];
        }
    }
    float cP = 1.f, cH = 0.f;
    if (PASS == 2 && !sample) {
        float2 ph[8];
#pragma unroll
        for (int i = 0; i < 8; ++i) { const int cc = sg0 * 8 + i; ph[i] = (cc < chunk) ? *(const float2*)(C.SUM + ((size_t)(b * 32 + cc) * 2048 + n * 128 + col) * 2) : make_float2(1.f, 0.f); }
#pragma unroll
        for (int i = 0; i < 8; ++i) { cH = ph[i].x * cH + ph[i].y; cP *= ph[i].x; }
    }
    v4u xr[2][4];
#pragma unroll
    for (int u = 0; u < 2; ++u) {
        const int idx = tid + u * 512, r = idx >> 4, c8 = (idx & 15) * 8, chn = n * 128 + c8;
#pragma unroll
        for (int j = 0; j < 4; ++j) {
            xr[u][j] = (v4u){0u, 0u, 0u, 0u};
            if (!sample) { const int t = chunk * 64 + r - 3 + j; if (t >= 0) xr[u][j] = *(const v4u*)(proj + ((size_t)b * TP + t) * 4096 + chn); }
            else { const int bb = r >> 3, tl = (r & 7) - 3 + j;
                if (tl >= 0) xr[u][j] = *(const v4u*)(proj + ((size_t)NPT + (bg * 8 + bb) * 8 + tl) * 4096 + chn); }
        }
    }
#pragma unroll
    for (int u = 0; u < 2; ++u) {
        const int idx = tid + u * 512, r = idx >> 4, c8 = (idx & 15) * 8, chn = n * 128 + c8;
        float acc[8];
        { const f32x4 b0 = *(const f32x4*)(C.in[20] + jl * 2048 + chn), b1 = *(const f32x4*)(C.in[20] + jl * 2048 + chn + 4);
          acc[0] = b0.x; acc[1] = b0.y; acc[2] = b0.z; acc[3] = b0.w; acc[4] = b1.x; acc[5] = b1.y; acc[6] = b1.z; acc[7] = b1.w; }
#pragma unroll
        for (int j = 0; j < 4; ++j) {
            float x[8]; unpack8(xr[u][j], x);
            if (sample && j < 3) { const int tl = (r & 7) - 3 + j;
                if (tl < 0) { const float* sp = C.in[6] + ((size_t)(jl * 128 + bg * 8 + (r >> 3)) * 3 + (3 + tl)) * 2048 + chn; const f32x4 h0v = *(const f32x4*)sp, h1v = *(const f32x4*)(sp + 4);
                    x[0] = h0v.x; x[1] = h0v.y; x[2] = h0v.z; x[3] = h0v.w; x[4] = h1v.x; x[5] = h1v.y; x[6] = h1v.z; x[7] = h1v.w; } }
            const f32x4 w0 = *(const f32x4*)(cw + j * 2048 + chn), w1 = *(const f32x4*)(cw + j * 2048 + chn + 4);
            acc[0] += x[0] * w0.x; acc[1] += x[1] * w0.y; acc[2] += x[2] * w0.z; acc[3] += x[3] * w0.w;
            acc[4] += x[4] * w1.x; acc[5] += x[5] * w1.y; acc[6] += x[6] * w1.z; acc[7] += x[7] * w1.w;
            if (PASS >= 2 && j == 3) {
                float* o = nullptr;
                if (!sample) { if (chunk == 31 && r >= 61) o = C.out + O_PLCONV + ((size_t)(jl * 4 + b) * 3 + (r - 61)) * 2048 + chn; }
                else { if ((r & 7) >= 5) o = C.out + O_SLCONV + ((size_t)(jl * 128 + bg * 8 + (r >> 3)) * 3 + ((r & 7) - 5)) * 2048 + chn; }
                if (o) { *(f32x4*)o = (f32x4){x[0], x[1], x[2], x[3]}; *(f32x4*)(o + 4) = (f32x4){x[4], x[5], x[6], x[7]}; }
            }
        }
        *(LAS f32x4*)(sXC + r * 132 + c8) = (f32x4){acc[0], acc[1], acc[2], acc[3]};
        *(LAS f32x4*)(sXC + r * 132 + c8 + 4) = (f32x4){acc[4], acc[5], acc[6], acc[7]};
        *(LAS v4u*)(sXB + r * 136 + c8) = pack8(acc);
    }
    if (PASS == 2 && !sample) { sCP[sg0 * 128 + col] = cP; sCH[sg0 * 128 + col] = cH; }
    __syncthreads();
    if (PASS == 2 && !sample && tid < 128) {
        float hc = 0.f;
#pragma unroll
        for (int q = 0; q < 4; ++q) hc = sCP[q * 128 + tid] * hc + sCH[q * 128 + tid];
        sCarry[tid] = hc;
    }
    {
        f32x4 accA[4], accX[4];
#pragma unroll
        for (int m = 0; m < 4; ++m) { accA[m] = (f32x4){0.f, 0.f, 0.f, 0.f}; accX[m] = accA[m]; }
#pragma unroll
        for (int kk = 0; kk < 4; ++kk) {
#pragma unroll
            for (int m = 0; m < 4; ++m) {
                const bf16x8 a = *(const LAS bf16x8*)(sXB + (m * 16 + l15) * 136 + kk * 32 + quad * 8);
                accA[m] = __builtin_amdgcn_mfma_f32_16x16x32_bf16(a, bA[kk], accA[m], 0, 0, 0);
                accX[m] = __builtin_amdgcn_mfma_f32_16x16x32_bf16(a, bX[kk], accX[m], 0, 0, 0);
            }
        }
        const float c2 = -8.0f * 1.4426950408889634f * softplusf_(-lam);
#pragma unroll
        for (int m = 0; m < 4; ++m)
#pragma unroll
            for (int j = 0; j < 4; ++j) {
                const int row = m * 16 + quad * 4 + j;
                const float rg = sigmoidf_(accA[m][j] + ba), ig = sigmoidf_(accX[m][j] + bx_);
                const float a = __builtin_amdgcn_exp2f(c2 * rg);
                float mult = __builtin_amdgcn_sqrtf(fmaxf(1.0f - a * a, 0.f));
                if (!sample && chunk == 0 && row == 0) mult = 1.0f;
                sAa[row * 132 + d] = a; sBb[row * 132 + d] = mult * ig * sXC[row * 132 + d];
            }
    }
    __syncthreads();
#pragma unroll
    for (int q = 0; q < 2; ++q) {
        const int sgm = sg0 + 4 * q;
        float P = 1.f, hh = 0.f;
#pragma unroll
        for (int r8 = 0; r8 < 8; ++r8) { const int row = sgm * 8 + r8; const float a = sAa[row * 132 + col]; hh = a * hh + sBb[row * 132 + col]; P *= a; }
        sSegP[sgm * 128 + col] = P; sSegH[sgm * 128 + col] = hh;
    }
    __syncthreads();
    if (PASS == 3) {
        if (!sample && tid < 128) {
            float P = 1.f, hh = 0.f;
#pragma unroll
            for (int s = 0; s < 8; ++s) { const float ps = sSegP[s * 128 + tid]; hh = ps * hh + sSegH[s * 128 + tid]; P *= ps; }
            unsigned long long* gr = C.CARRY + ((size_t)((jl * 4 + b) * 32 + chunk) * 2048 + n * 128 + tid);
            float cin = 0.f;
            if (chunk > 0) {
                unsigned long long g = 0ull; unsigned spins = 0;
                for (;;) { g = __hip_atomic_load(gr - 2048, __ATOMIC_RELAXED, __HIP_MEMORY_SCOPE_AGENT); if ((unsigned)(g >> 32) == 1u || ++spins > (1u << 20)) break; __builtin_amdgcn_s_sleep(1); }
                cin = __uint_as_float((unsigned)g);
            }
            const float cout = P * cin + hh;
            __hip_atomic_store(gr, (1ull << 32) | (unsigned long long)__float_as_uint(cout), __ATOMIC_RELAXED, __HIP_MEMORY_SCOPE_AGENT);
            sCarry[tid] = cin;
        }
        __syncthreads();
    }
    if (PASS == 1) {
        if (tid < 128) {
            float P = 1.f, hh = 0.f;
#pragma unroll
            for (int s = 0; s < 8; ++s) { const float ps = sSegP[s * 128 + tid]; hh = ps * hh + sSegH[s * 128 + tid]; P *= ps; }
            *(float2*)(C.SUM + ((size_t)(b * 32 + chunk) * 2048 + n * 128 + tid) * 2) = make_float2(P, hh);
        }
    } else {
#pragma unroll
        for (int q = 0; q < 2; ++q) {
            const int sgm = sg0 + 4 * q;
            float hh;
            if (sample) hh = h0[q];
            else { hh = sCarry[col]; for (int s = 0; s < sgm; ++s) hh = sSegP[s * 128 + col] * hh + sSegH[s * 128 + col]; }
#pragma unroll
            for (int r8 = 0; r8 < 8; ++r8) {
                const int row = sgm * 8 + r8;
                hh = sAa[row * 132 + col] * hh + sBb[row * 132 + col];
                const float gate = bf2f(gt[q * 8 + r8]);
                C.O[(tok0 + row) * DM + n * 128 + col] = (bf16)f2bf(hh * siluf_(gate));
            }
            if (sample) C.out[O_SLRU + (size_t)(jl * 128 + bg * 8 + sgm) * 2048 + n * 128 + col] = hh;
            else if (chunk == 31 && sgm == 7) C.out[O_PLRU + (size_t)(jl * 4 + b) * 2048 + n * 128 + col] = hh;
        }
    }
    __syncthreads();
}

#define XB_TMO      128
#define XB_XCNT(j)  (256  + 64 * (j))
#define XB_XSUB(j)  (1280 + 64 * (j))
#define XB_XGEN(j)  (2304 + 64 * (j))
#define XB_TOP      3328
#define XB_TOPGEN   3392
#define XCD_BAR_WORDS 3456
#define XB_SPIN_CAP (1u << 18)

__device__ __forceinline__ unsigned xb_ld(unsigned* p)              { return __hip_atomic_load(p, __ATOMIC_RELAXED, __HIP_MEMORY_SCOPE_AGENT); }
__device__ __forceinline__ unsigned xb_add(unsigned* p, unsigned v) { return __hip_atomic_fetch_add(p, v, __ATOMIC_RELAXED, __HIP_MEMORY_SCOPE_AGENT); }
__device__ __forceinline__ unsigned xb_xcc_id() { return (unsigned)__builtin_amdgcn_s_getreg((3 << 11) | 20) & 0xFu; }
#define XB_SPIN(cond, bar) do { unsigned _sp = 0; while (cond) { __builtin_amdgcn_s_sleep(1); \
    if ((++_sp & 255u) == 0u) { if (xb_ld(&(bar)[XB_TMO])) break; if (_sp > XB_SPIN_CAP) { atomicAdd(&(bar)[XB_TMO], 1u); break; } } } } while (0)

struct XcdBarrier {
    unsigned* bar; unsigned x;
    volatile LAS unsigned* st;
};

__device__ __forceinline__ XcdBarrier xcd_barrier_post(unsigned* bar, volatile LAS unsigned* st) {
    XcdBarrier b; b.bar = bar; b.x = xb_xcc_id(); b.st = st;
    if (threadIdx.x == 0) (void)xb_add(&bar[XB_XCNT(b.x)], 1u);
    return b;
}
__device__ __forceinline__ void xcd_barrier_complete(unsigned* bar, unsigned x, unsigned& nloc, unsigned& nx) {
    const unsigned G = gridDim.x * gridDim.y * gridDim.z;
    unsigned sum, cnt, mine, sp = 0u;
    for (;;) {
        sum = 0u; cnt = 0u; mine = 0u;
#pragma unroll
        for (unsigned j = 0; j < 16; ++j) { const unsigned c = xb_ld(&bar[XB_XCNT(j)]); sum += c; cnt += (c > 0u) ? 1u : 0u; mine = (j == x) ? c : mine; }
        if (sum == G) break;
        __builtin_amdgcn_s_sleep(1);
        if ((++sp & 255u) == 0u) { if (xb_ld(&bar[XB_TMO])) break; if (sp > XB_SPIN_CAP) { atomicAdd(&bar[XB_TMO], 1u); break; } }
    }
    nloc = mine > 0u ? mine : 1u; nx = cnt > 0u ? cnt : 1u;
}

__device__ __forceinline__ void xcd_barrier(const XcdBarrier& b) {
    asm volatile("s_waitcnt vmcnt(0)" ::: "memory");
    __syncthreads();
    if (threadIdx.x == 0) {
        unsigned* bar = b.bar;
        __builtin_amdgcn_s_waitcnt(0);
        unsigned nloc = b.st[0], nx = b.st[1];
        if (nloc == 0u) { xcd_barrier_complete(bar, b.x, nloc, nx); b.st[0] = nloc; b.st[1] = nx; }
        const unsigned old = xb_add(&bar[XB_XSUB(b.x)], 1u);
        const unsigned gen = old / nloc;
        if (old + 1u == (gen + 1u) * nloc) {
            __builtin_amdgcn_fence(__ATOMIC_RELEASE, "agent");
            asm volatile("s_waitcnt vmcnt(0)" ::: "memory");
            const unsigned og = xb_add(&bar[XB_TOP], 1u);
            const unsigned tg = og / nx;
            if (og + 1u == (tg + 1u) * nx) xb_add(&bar[XB_TOPGEN], 1u);
            else XB_SPIN(xb_ld(&bar[XB_TOPGEN]) == tg, bar);
            __builtin_amdgcn_fence(__ATOMIC_ACQUIRE, "agent");
            xb_add(&bar[XB_XGEN(b.x)], 1u);
            asm volatile("s_waitcnt vmcnt(0)" ::: "memory");
        } else {
            XB_SPIN(xb_ld(&bar[XB_XGEN(b.x)]) == gen, bar);
            __builtin_amdgcn_fence(__ATOMIC_ACQUIRE, "agent");
            asm volatile("s_waitcnt vmcnt(0)" ::: "memory");
        }
    }
    __syncthreads();
}

struct OneUnit {
    int pm, pn;
    __device__ bool next(int i, pg8::Unit& u) const { if (i != 0) return false; u.pm = pm; u.pn = pn; return true; }
    __device__ __forceinline__ void a_ready(const pg8::Unit&) const {}
    __device__ __forceinline__ void done(const pg8::Unit&) const {}
};
constexpr int TAB_OFF = 143360;
__device__ __forceinline__ unsigned long long tab_ld(LAS unsigned char* lds, int i) {
    const volatile LAS unsigned* t = (const volatile LAS unsigned*)(lds + TAB_OFF) + 2 * i;
    const unsigned lo = __builtin_amdgcn_readfirstlane(t[0]), hi = __builtin_amdgcn_readfirstlane(t[1]);
    return ((unsigned long long)hi << 32) | lo;
}
__device__ __forceinline__ Ctx make_ctx(LAS unsigned char* lds) {
    Ctx C;
#pragma unroll
    for (int i = 0; i < 28; ++i) C.in[i] = (const float*)tab_ld(lds, i);
    C.out = (float*)tab_ld(lds, 28);
    unsigned char* ws = (unsigned char*)tab_ld(lds, 29);
    C.G = gridDim.x;
    C.WABIN = (bf16*)(ws + WS_WABIN); C.WABOUT = (bf16*)(ws + WS_WABOUT); C.WLIN = (bf16*)(ws + WS_WLIN); C.WLOUT = (bf16*)(ws + WS_WLOUT);
    C.WLA = (bf16*)(ws + WS_WLA); C.WLX = (bf16*)(ws + WS_WLX);
    C.X = (float*)(ws + WS_X); C.H = (bf16*)(ws + WS_H); C.O = (bf16*)(ws + WS_O); C.PROJ = (bf16*)(ws + WS_PROJ);
    C.G_W = (bf16*)(ws + WS_GW); C.G_QG = (bf16*)(ws + WS_GQG); C.G_KDT = (bf16*)(ws + WS_GKDT); C.G_QK = (bf16*)(ws + WS_GQK); C.G_UT = (float*)(ws + WS_GUT);
    C.L_QG = (bf16*)(ws + WS_LQG); C.L_KDT = (bf16*)(ws + WS_LKDT); C.L_A = (bf16*)(ws + WS_LA); C.L_VT = (bf16*)(ws + WS_LVT);
    C.G_DEC = (float*)(ws + WS_GDEC); C.L_DEC = (float*)(ws + WS_LDEC); C.SUM = (float*)(ws + WS_SUM); C.SS = (float*)(ws + 65536); C.CARRY = (unsigned long long*)(ws + WS_CARRY);
    return C;
}
#ifndef TYPE_MASK
#define TYPE_MASK 0xFFFF
#endif
#define TY(t) ((TYPE_MASK >> (t)) & 1)
#ifndef REP_MASK
#define REP_MASK 0
#endif
#define REP(t) for (int rep_ = 0; rep_ < (((REP_MASK >> (t)) & 1) ? 2 : 1); ++rep_)
__global__ void __launch_bounds__(512, 2) mk_fwd(Params p) {
    extern __shared__ __attribute__((aligned(16))) unsigned char lds_raw[];
    LAS unsigned char* lds = (LAS unsigned char*)lds_raw;
    if (threadIdx.x == 0) {
        LAS unsigned long long* t = (LAS unsigned long long*)(lds + TAB_OFF);
#pragma unroll
        for (int i = 0; i < 28; ++i) t[i] = (unsigned long long)p.in[i];
        t[28] = (unsigned long long)p.out; t[29] = (unsigned long long)p.ws;
    }
    if (threadIdx.x < 2) ((LAS unsigned*)(lds + TAB_OFF + 256))[threadIdx.x] = 0u;
    __syncthreads();
    const int lo = p.ph_lo, hi = p.ph_hi;
    const int G = gridDim.x;
    cg::grid_group grid = cg::this_grid();
    XcdBarrier xbar; xbar.bar = (unsigned*)p.ws; xbar.x = 0; xbar.st = nullptr;
    if (hi - lo > 1) xbar = xcd_barrier_post((unsigned*)p.ws, (volatile LAS unsigned*)(lds + TAB_OFF + 256));
#define IN(k) (lo <= (k) && (k) < hi)
#define SEAM2(k, kn) do { if (IN(k) && IN(kn)) { xcd_barrier(xbar); } } while (0)
    if (hi < 0) grid.sync();
#define SEAM(k) do { if (IN(k) && IN((k) + 1)) { xcd_barrier(xbar); } } while (0)
#define GW_DECL const int tid_ = otid(), bid = obid(), lane = tid_ & 63, gw = bid * 8 + (tid_ >> 6), NGW = G * 8

    REP(0) if (TY(0) && IN(0)) { const Ctx C = make_ctx(lds); prologue_phase(C, lds); }
    SEAM(0);
#pragma unroll 1
    for (int l = 0; l < 4; ++l) {
        const int j = l >> 1;
        if ((l & 1) == 0) {
            const int P0 = (l == 0) ? 1 : 12;
            REP(1) if (TY(1) && IN(P0)) {
                const Ctx C = make_ctx(lds); const int bid = obid();
                pg8::Gemm g{C.H, C.WABIN + (size_t)j * ABNP * 2048, NTOK, ABNP, DM}; pg8::StaticOrder S; S.init(NTOK, ABNP, G, bid);
                pg8::EpiProj E{C.PROJ, ABNP, (l == 0) ? (const float*)nullptr : C.SS + (size_t)(l - 1) * NTOK};
                pg8::gemm_phase<pg8::EpiProj, pg8::StaticOrder, true, true>(lds, g, S, E);
                if (l == 0 && G == 256) convert_segment(C, lds, 1, 20);
            }
            SEAM(P0);
            REP(2) if (TY(2) && IN(P0 + 1)) {
                const Ctx C = make_ctx(lds); const int bid = obid();
                for (int it = bid; it < 1536; it += G) { if (it < 1024) gdn_prep_item(C, j, it, lds); else gla_prep_item(C, j, it - 1024, lds); }
            }
            SEAM(P0 + 1);
            REP(3) if (TY(3) && IN(P0 + 2)) {
                const Ctx C = make_ctx(lds); const int bid = obid();
                REP(13) if (G == 256) {
                    const int xcd = bid & 7, slot = bid >> 3;
                    if (slot < 16) scan_task<true>(C, j, (xcd * 4 + (slot >> 2)) * 4 + (slot & 3), lds);
                    else scan_task<false>(C, j, (xcd * 2 + ((slot - 16) >> 3)) * 8 + ((slot - 16) & 7), lds);
                } else
                for (int t = bid; t < 256; t += G) { if (t < 128) scan_task<true>(C, j, t, lds); else scan_task<false>(C, j, t - 128, lds); }
                for (int it = bid; it < 1536; it += G) { if (it < 1024) gdn_sample_item(C, j, it, lds); else gla_sample_item(C, j, it - 1024, lds); }
            }
            SEAM(P0 + 2);
            REP(4) if (TY(4) && IN(P0 + 3)) {
                const Ctx C = make_ctx(lds);
                if (G == 256) {
                    const int bid = obid();
                    if (bid < 32) {
                        const float* resS = (l == 0) ? C.in[1] : C.X + (size_t)NPT * DM;
                        pg8::Gemm g{C.O, C.WABOUT + (size_t)j * 2048 * 2048, NTOK, DM, DM}; OneUnit S1{32 + (bid >> 3), bid & 7};
                        pg8::EpiRes E{C.X, resS, C.X, DM, C.H, C.in[17] + j * DM, C.SS + (size_t)l * NTOK};
                        pg8::gemm_phase<pg8::EpiRes, OneUnit, true, true>(lds, g, S1, E);
                    } else {
                        const int tid_ = otid(), lane = tid_ & 63;
                        gatenorm_phase(C, j, (bid - 32) * 8 + (tid_ >> 6), 224 * 8, lane);
                        if (l == 0) convert_segment(C, lds, 2, 32);
                    }
                } else { GW_DECL; gatenorm_phase(C, j, gw, NGW, lane); }
            }
            SEAM(P0 + 3);
            REP(5) if (TY(5) && IN(P0 + 4)) {
                const Ctx C = make_ctx(lds); const int bid = obid();
                const float* resP = (l == 0) ? C.in[0] : C.X;
                const float* resS = (l == 0) ? C.in[1] : C.X + (size_t)NPT * DM;
                pg8::Gemm g{C.O, C.WABOUT + (size_t)j * 2048 * 2048, NTOK, DM, DM}; pg8::StaticOrder S; S.init((G == 256) ? NPT : NTOK, DM, G, bid);
                pg8::EpiRes E{resP, resS, C.X, DM, C.H, C.in[17] + j * DM, C.SS + (size_t)l * NTOK};
                pg8::gemm_phase<pg8::EpiRes, pg8::StaticOrder, true, true>(lds, g, S, E);
            }
            SEAM2(P0 + 4, P0 + 6);
        } else {
            const int P0 = (l == 1) ? 7 : 18;
            REP(7) if (TY(7) && IN(P0)) {
                const Ctx C = make_ctx(lds); const int bid = obid();
                pg8::Gemm g{C.H, C.WLIN + (size_t)j * 4096 * 2048, NTOK, 4096, DM}; pg8::StaticOrder S; S.init(NTOK, 4096, G, bid);
                pg8::EpiProj E{C.PROJ, 4096, C.SS + (size_t)(l - 1) * NTOK};
                pg8::gemm_phase<pg8::EpiProj, pg8::StaticOrder, true, true>(lds, g, S, E);
                if (l == 1 && G == 256) convert_segment(C, lds, 3, 64);
            }
            SEAM2(P0, P0 + 2);
            REP(9) if (TY(9) && IN(P0 + 2)) { const Ctx C = make_ctx(lds); const int bid = obid(); for (int it = bid; it < 2304; it += G) lru_item<3>(C, j, it, lds); }
            SEAM(P0 + 2);
            REP(10) if (TY(10) && IN(P0 + 3)) {
                const Ctx C = make_ctx(lds); const int bid = obid();
                pg8::Gemm g{C.O, C.WLOUT + (size_t)j * 2048 * 2048, NTOK, DM, DM}; pg8::StaticOrder S; S.init(NTOK, DM, G, bid);
                pg8::EpiRes E{C.X, C.X + (size_t)NPT * DM, C.X, DM, (l == 1) ? C.H : (bf16*)nullptr, C.in[7] + DM, C.SS + (size_t)l * NTOK};
                pg8::gemm_phase<pg8::EpiRes, pg8::StaticOrder, true, true>(lds, g, S, E);
                if (l == 1 && G == 256) convert_segment(C, lds, 4, 32);
            }
            if (l == 1) SEAM2(P0 + 3, P0 + 5); else SEAM(P0 + 3);
            REP(11) if (TY(11) && IN(P0 + 4)) {
                const Ctx C = make_ctx(lds); GW_DECL;
                if (l == 3) rms_phase_f32(C.X, C.in[27], C.out, gw, NGW, lane);
            }
        }
    }
#undef IN
#undef SEAM
}

extern "C" void kernel_launch(void* const* d_in, const int* in_sizes, int n_in, void* d_out, int out_size, void* d_ws, size_t ws_size, hipStream_t stream) {
    static int grid = 0;
    if (grid == 0) {
        if (n_in != 28 || ws_size < WS_END || (size_t)out_size != O_END) { fprintf(stderr, "kernel_launch: unexpected problem (n_in %d, out %d, ws %zu)\n", n_in, out_size, ws_size); grid = -1; return; }
        int dev = 0, cus = 0, per_cu = 0;
        if (hipGetDevice(&dev) != hipSuccess || hipDeviceGetAttribute(&cus, hipDeviceAttributeMultiprocessorCount, dev) != hipSuccess) { grid = -1; return; }
        if (hipFuncSetAttribute((const void*)mk_fwd, hipFuncAttributeMaxDynamicSharedMemorySize, LDS_BYTES) != hipSuccess) { fprintf(stderr, "kernel_launch: hipFuncSetAttribute failed\n"); grid = -1; return; }
        if (hipOccupancyMaxActiveBlocksPerMultiprocessor(&per_cu, (const void*)mk_fwd, 512, LDS_BYTES) != hipSuccess || per_cu < 1) { fprintf(stderr, "kernel_launch: occupancy query says %d\n", per_cu); per_cu = 1; }
        (void)hipGetLastError();
        grid = cus * per_cu;
    }
    if (grid < 0) return;
    if (hipMemsetAsync(d_ws, 0, 262144, stream) != hipSuccess) { fprintf(stderr, "kernel_launch: memset failed\n"); return; }
    if (hipMemsetAsync((char*)d_ws + WS_CARRY, 0, 4 * MiB, stream) != hipSuccess) { fprintf(stderr, "kernel_launch: memset failed\n"); return; }
    Params p{};
    for (int i = 0; i < 28; ++i) p.in[i] = (const float*)d_in[i];
    p.out = (float*)d_out; p.ws = (unsigned char*)d_ws;
#if ONE_LAUNCH
    p.ph_lo = 0; p.ph_hi = NPHASE;
    void* args[] = {&p};
    hipError_t e = hipLaunchCooperativeKernel((const void*)mk_fwd, dim3(grid), dim3(512), args, LDS_BYTES, stream);
    if (e != hipSuccess) fprintf(stderr, "cooperative launch failed: %s (grid %d)\n", hipGetErrorString(e), grid);
#else
    for (int k = 0; k < NPHASE; ++k) {
        p.ph_lo = k; p.ph_hi = k + 1;
        hipLaunchKernelGGL(mk_fwd, dim3(grid), dim3(512), LDS_BYTES, stream, p);
    }
#endif
}
```
